# Optimizing an MI355X kernel written in HIP

```python
import math
import jax, jax.numpy as jnp
from jax import lax
import numpy as np

D_MODEL = 2048
BATCH = 4
SEQ = 4096
DEPTH = 2

MIX = D_MODEL
D_MLA = MIX // 2
D_CONV = MIX - D_MLA
N_HEADS = 8
NOPE_DIM = 128
ROPE_DIM = 64
V_DIM = D_MLA // N_HEADS
QK_DIM = NOPE_DIM + ROPE_DIM
Q_LORA = 512
KV_LORA = 256
ROPE_THETA = 10000.0
Q_BLOCK = 128
CONV_K = 31
IN_COLS = Q_LORA + KV_LORA + ROPE_DIM + D_MLA + 2 * D_CONV + D_CONV
EPS = 1e-6

kernel_name = "hybrid_mla_conformer_conv_headgroups"


def rms_norm(x, g):
    xf = x.astype(jnp.float32)
    y = xf * lax.rsqrt(jnp.mean(xf * xf, axis=-1, keepdims=True) + EPS)
    return (y * g.astype(jnp.float32)).astype(x.dtype)


def layer_norm(x, g, b):
    xf = x.astype(jnp.float32)
    mu = jnp.mean(xf, axis=-1, keepdims=True)
    var = jnp.mean(jnp.square(xf - mu), axis=-1, keepdims=True)
    y = (xf - mu) * lax.rsqrt(var + EPS)
    return (y * g.astype(jnp.float32) + b.astype(jnp.float32)).astype(x.dtype)


def rope_tables(positions, dtype):
    inv_freq = 1.0 / (ROPE_THETA ** (jnp.arange(0, ROPE_DIM, 2, dtype=jnp.float32) / ROPE_DIM))
    ang = positions.astype(jnp.float32)[..., None] * inv_freq
    return jnp.cos(ang)[:, :, None, :].astype(dtype), jnp.sin(ang)[:, :, None, :].astype(dtype)


def apply_rope(x, cos, sin):
    x1, x2 = jnp.split(x, 2, axis=-1)
    return jnp.concatenate([x1 * cos - x2 * sin, x2 * cos + x1 * sin], axis=-1)


def causal_block_attention(q, k, v):
    b, s, h, dq = q.shape
    nb = s // Q_BLOCK
    scale = 1.0 / math.sqrt(dq)
    qb = q.reshape(b, nb, Q_BLOCK, h, dq).transpose(1, 0, 2, 3, 4)
    key_pos = jnp.arange(s)

    def one_block(args):
        q_i, blk = args
        scores = jnp.einsum('bqhd,bkhd->bhqk', q_i, k).astype(jnp.float32) * scale
        q_pos = blk * Q_BLOCK + jnp.arange(Q_BLOCK)
        mask = key_pos[None, :] <= q_pos[:, None]
        scores = jnp.where(mask[None, None], scores, -jnp.inf)
        p = jax.nn.softmax(scores, axis=-1).astype(v.dtype)
        return jnp.einsum('bhqk,bkhd->bqhd', p, v)

    out = lax.map(one_block, (qb, jnp.arange(nb)))
    return out.transpose(1, 0, 2, 3, 4).reshape(b, s, h, v.shape[-1])


def causal_depthwise_conv(u, w, bias):
    out = lax.conv_general_dilated(
        u, w[:, None, :].astype(u.dtype),
        window_strides=(1,), padding=((CONV_K - 1, 0),),
        dimension_numbers=('NWC', 'WIO', 'NWC'),
        feature_group_count=u.shape[-1])
    return out + bias


def setup_inputs(seed: int = 0) -> dict:
    key = jax.random.key(seed)
    ks = jax.random.split(key, 24)
    f32 = jnp.float32

    def w(k, shape, fan_in):
        return jax.random.normal(k, shape, f32) * (fan_in ** -0.5)

    def gain(k, shape):
        return 1.0 + 0.05 * jax.random.normal(k, shape, f32)

    def small(k, shape):
        return 0.02 * jax.random.normal(k, shape, f32)

    x = jax.random.normal(ks[0], (BATCH, SEQ, D_MODEL), f32)
    c = jax.random.normal(ks[1], (BATCH, D_MODEL), f32)
    offsets = jax.random.randint(ks[2], (BATCH, 1), 0, 1024, dtype=jnp.int32)
    positions = offsets + jnp.arange(SEQ, dtype=jnp.int32)[None, :]
    return {
        'x': x,
        'c': c,
        'positions': positions,
        'ada_w': w(ks[3], (DEPTH, D_MODEL, 3 * D_MODEL), D_MODEL),
        'ada_b': small(ks[4], (DEPTH, 3 * D_MODEL)),
        'norm_g': gain(ks[5], (DEPTH, D_MODEL)),
        'w_in': w(ks[6], (DEPTH, D_MODEL, IN_COLS), D_MODEL),
        'q_lat_g': gain(ks[7], (DEPTH, Q_LORA)),
        'w_q_up': w(ks[8], (DEPTH, Q_LORA, N_HEADS * QK_DIM), Q_LORA),
        'kv_lat_g': gain(ks[9], (DEPTH, KV_LORA)),
        'w_kv_up': w(ks[10], (DEPTH, KV_LORA, N_HEADS * (NOPE_DIM + V_DIM)), KV_LORA),
        'q_norm_g': gain(ks[11], (DEPTH, QK_DIM)),
        'k_norm_g': gain(ks[12], (DEPTH, QK_DIM)),
        'glu_b': small(ks[13], (DEPTH, 2 * D_CONV)),
        'dw_w': w(ks[14], (DEPTH, CONV_K, D_CONV), CONV_K),
        'dw_b': small(ks[15], (DEPTH, D_CONV)),
        'conv_ln_g': gain(ks[16], (DEPTH, D_CONV)),
        'conv_ln_b': small(ks[17], (DEPTH, D_CONV)),
        'w_pw': w(ks[18], (DEPTH, D_CONV, D_CONV), D_CONV),
        'b_pw': small(ks[19], (DEPTH, D_CONV)),
        'w_out': w(ks[20], (DEPTH, MIX, D_MODEL), MIX),
    }


def reference(x, c, positions, ada_w, ada_b, norm_g, w_in, q_lat_g, w_q_up, kv_lat_g,
              w_kv_up, q_norm_g, k_norm_g, glu_b, dw_w, dw_b, conv_ln_g, conv_ln_b,
              w_pw, b_pw, w_out):
    b, s, _ = x.shape
    cos, sin = rope_tables(positions, x.dtype)
    c_act = jax.nn.silu(c)
    splits = np.cumsum([Q_LORA, KV_LORA, ROPE_DIM, D_MLA, 2 * D_CONV]).tolist()

    for l in range(DEPTH):
        mod = c_act @ ada_w[l] + ada_b[l]
        shift, scale, gate = [m[:, None, :] for m in jnp.split(mod, 3, axis=-1)]
        h = rms_norm(x, norm_g[l]) * (1.0 + scale) + shift

        z = h @ w_in[l]
        q_lat, kv_lat, k_rope, mla_gate, conv_in, conv_gate = jnp.split(z, splits, axis=-1)

        q = (rms_norm(q_lat, q_lat_g[l]) @ w_q_up[l]).reshape(b, s, N_HEADS, QK_DIM)
        kv = (rms_norm(kv_lat, kv_lat_g[l]) @ w_kv_up[l]).reshape(b, s, N_HEADS, NOPE_DIM + V_DIM)
        k_nope, v = kv[..., :NOPE_DIM], kv[..., NOPE_DIM:]
        k_rope_h = jnp.broadcast_to(k_rope[:, :, None, :], (b, s, N_HEADS, ROPE_DIM))
        k = jnp.concatenate([k_nope, k_rope_h], axis=-1)
        q = rms_norm(q, q_norm_g[l])
        k = rms_norm(k, k_norm_g[l])
        q = jnp.concatenate([q[..., :NOPE_DIM], apply_rope(q[..., NOPE_DIM:], cos, sin)], axis=-1)
        k = jnp.concatenate([k[..., :NOPE_DIM], apply_rope(k[..., NOPE_DIM:], cos, sin)], axis=-1)
        attn = causal_block_attention(q, k, v).reshape(b, s, D_MLA)
        mla_out = attn * jax.nn.silu(mla_gate)

        u_val, u_gate = jnp.split(conv_in + glu_b[l], 2, axis=-1)
        u = u_val * jax.nn.sigmoid(u_gate)
        u = causal_depthwise_conv(u, dw_w[l], dw_b[l])
        u = jax.nn.silu(layer_norm(u, conv_ln_g[l], conv_ln_b[l]))
        u = u @ w_pw[l] + b_pw[l]
        conv_out = u * jax.nn.silu(conv_gate)

        y = jnp.concatenate([mla_out, conv_out], axis=-1) @ w_out[l]
        x = x + gate * y
    return x
```

```cpp
#include <hip/hip_runtime.h>
#include <hip/hip_cooperative_groups.h>
#include <cstdio>
#include <cstdint>
namespace cg = cooperative_groups;

constexpr int DM = 2048, NB = 4, SEQ = 4096, T = NB * SEQ, DEPTH = 2;
constexpr int NH = 8, QKD = 192, VD = 128, QL = 512, KVL = 256, DC = 1024, CK = 31;
constexpr int INC = 4928, INCP = 5120;
constexpr int Z_KVL = 512, Z_KR = 768, Z_MG = 832, Z_CV = 1856, Z_CGL = 2880, Z_CG = 3904;
constexpr int KQ = 512, KK = 384, KV = 256;
constexpr float EPS = 1e-6f;

template <int K> __device__ __forceinline__ float xshfl(float v) { static_assert(K >= 1 && K < 32, "xshfl"); return __int_as_float(__builtin_amdgcn_ds_swizzle(__float_as_int(v), (K << 10) | 0x1f)); }
__device__ __forceinline__ float xsum32(float v) { auto rr = __builtin_amdgcn_permlane32_swap(__float_as_uint(v), __float_as_uint(v), false, false); return __uint_as_float(rr[0]) + __uint_as_float(rr[1]); }
__device__ __forceinline__ float xswap32(float v, bool upper) { auto rr = __builtin_amdgcn_permlane32_swap(__float_as_uint(v), __float_as_uint(v), false, false); return __uint_as_float(upper ? rr[0] : rr[1]); }
__device__ __forceinline__ float wave_sum(float v) { v += xshfl<1>(v); v += xshfl<2>(v); v += xshfl<4>(v); v += xshfl<8>(v); v += xshfl<16>(v); return xsum32(v); }
namespace pg8 {
#define PG8_LAS __attribute__((address_space(3)))
typedef unsigned short bf16_t;
typedef short bf16x8 __attribute__((ext_vector_type(8)));
typedef float f32x4 __attribute__((ext_vector_type(4)));
typedef unsigned u32x4 __attribute__((ext_vector_type(4)));
constexpr int BM = 256, BK = 64, HALF = 128, HTB = HALF * BK * 2  , STAGE_BYTES = 8 * HTB, NXCD = 8, WGM = 4;

__host__ __device__ __forceinline__ int lds_byte(int r, int c) { const int st = (r >> 4) * 2 + (c >> 5), rr = r & 15, cc = c & 31, ob = rr * 64 + cc * 2; return st * 1024 + (ob ^ (((ob >> 9) & 1) << 5)); }
__host__ __device__ __forceinline__ void stage_rc(int b, int& R, int& C) { const int st = b / 1024, sb = b % 1024, swz = sb ^ (((sb >> 9) & 1) << 5); R = (st >> 1) * 16 + swz / 64; C = (st & 1) * 32 + (swz % 64) / 2; }
__host__ __device__ __forceinline__ int perm32(int rho) { const int n = rho >> 4, i = rho & 15; return 8 * (i >> 2) + 4 * n + (i & 3); }

struct Unit { int pm, pn; };
struct Gemm { const bf16_t* A; const bf16_t* Bt; int M, N, K, lda, ldb; };

struct StaticOrder {
    int nM, nN, nwg, G, c, wgm;
    __host__ __device__ void init(int M, int N, int G_, int c_, int wgm_ = WGM) { nM = M / BM; nN = N / BM; nwg = nM * nN; G = G_; c = c_; wgm = wgm_; }
    __host__ __device__ bool next(int i, Unit& u) const {
        const int L = i * G + c; if (L >= nwg) return false;
        int wgid = L; { const int q = nwg / NXCD, r = nwg % NXCD, xcd = wgid % NXCD, off = wgid / NXCD; wgid = (xcd < r ? xcd * (q + 1) : r * (q + 1) + (xcd - r) * q) + off; }
        const int nig = wgm * nN, gid = wgid / nig, fm = gid * wgm, gsz = (nM - fm) < wgm ? (nM - fm) : wgm;
        u.pm = fm + ((wgid % nig) % gsz); u.pn = (wgid % nig) / gsz; return true;
    }
    __device__ __forceinline__ void a_ready(const Unit&) const {}
    __device__ __forceinline__ void done(const Unit&) const {}
};
__device__ __forceinline__ unsigned cvt_pk_bf16(float lo, float hi) { unsigned r; asm volatile("v_cvt_pk_bf16_f32 %0, %1, %2" : "=v"(r) : "v"(lo), "v"(hi)); return r; }
typedef float f32x2 __attribute__((ext_vector_type(2)));
typedef unsigned u32x2 __attribute__((ext_vector_type(2)));
__device__ __forceinline__ float fast_silu(float v) { return v * __builtin_amdgcn_rcpf(1.0f + __builtin_amdgcn_exp2f(-1.4426950408889634f * v)); }
__device__ __forceinline__ float bf_lo(unsigned u) { return __uint_as_float(u << 16); }
__device__ __forceinline__ float bf_hi(unsigned u) { return __uint_as_float(u & 0xffff0000u); }

struct EpiZ {
    static constexpr bool PERM = true, AFTER_DRAIN = false;
    bf16_t* O; int ldc; const float* bias; int nvalid; float* ssq;
    __device__ __forceinline__ void operator()(const f32x4 (&acc)[2][2][4][2], const Unit& u, int wr, int wc, int fr, int fq) const {
        asm volatile("" : "+v"(fr), "+v"(fq), "+s"(wr), "+s"(wc));
        const int row0 = u.pm * BM + wr * 64 + fr; const int col0 = u.pn * BM + wc * 32 + 8 * fq;
        f32x4 bv[2][2];
#pragma unroll
        for (int bj = 0; bj < 2; ++bj)
#pragma unroll
            for (int n = 0; n < 2; ++n) bv[bj][n] = *(const f32x4*)(bias + col0 + bj * HALF + 4 * n);
        if (u.pn < 3) {
#pragma unroll
            for (int ai = 0; ai < 2; ++ai)
#pragma unroll
                for (int m = 0; m < 4; ++m) { float s = 0.f;
#pragma unroll
                    for (int bj = 0; bj < 2; ++bj)
#pragma unroll
                        for (int n = 0; n < 2; ++n) { const f32x4 x = acc[ai][bj][m][n] + bv[bj][n]; s += (x[0] * x[0] + x[1] * x[1]) + (x[2] * x[2] + x[3] * x[3]); }
                    s += xshfl<16>(s); s = xsum32(s);
                    if (fq == 0) ssq[(size_t)(row0 + ai * HALF + m * 16) * 12 + u.pn * 4 + wc] = s; }
        }
#pragma unroll
        for (int ai = 0; ai < 2; ++ai)
#pragma unroll
            for (int m = 0; m < 4; ++m) { bf16_t* rowp = O + (size_t)(row0 + ai * HALF + m * 16) * ldc + col0;
#pragma unroll
                for (int bj = 0; bj < 2; ++bj) { const f32x4 v0 = acc[ai][bj][m][0] + bv[bj][0], v1 = acc[ai][bj][m][1] + bv[bj][1];
                    u32x4 w; w.x = cvt_pk_bf16(v0[0], v0[1]); w.y = cvt_pk_bf16(v0[2], v0[3]); w.z = cvt_pk_bf16(v1[0], v1[1]); w.w = cvt_pk_bf16(v1[2], v1[3]);
                    if (col0 + bj * HALF < nvalid) *(u32x4*)(rowp + bj * HALF) = w; } }
    }
};
struct EpiV {
    static constexpr bool PERM = false, AFTER_DRAIN = false;
    bf16_t* O; const float* ssq;
    __device__ __forceinline__ void operator()(const f32x4 (&acc)[2][2][4][2], const Unit& u, int wr, int wc, int fr, int fq) const {
        asm volatile("" : "+v"(fr), "+v"(fq), "+s"(wr), "+s"(wc));
        const int t0 = u.pm * BM, b = t0 / SEQ, s0 = t0 % SEQ;
        float rk8[2][4];
#pragma unroll
        for (int ai = 0; ai < 2; ++ai)
#pragma unroll
            for (int m = 0; m < 4; ++m) { const f32x4 sl = *(const f32x4*)(ssq + (size_t)(t0 + ai * HALF + wr * 64 + m * 16 + fr) * 12 + 8);
                rk8[ai][m] = __builtin_amdgcn_rsqf(((sl[0] + sl[1]) + (sl[2] + sl[3])) * (1.0f / 256.0f) + 1e-6f); }
#pragma unroll
        for (int ai = 0; ai < 2; ++ai)
#pragma unroll
            for (int m = 0; m < 4; ++m) { const int r = ai * HALF + wr * 64 + m * 16 + fr;
                const float rk = rk8[ai][m];
#pragma unroll
                for (int bj = 0; bj < 2; ++bj) { bf16_t* dst = O + ((size_t)((b * NH + 2 * u.pn + bj) * SEQ + s0 + r)) * VD + wc * 32 + 4 * fq;
#pragma unroll
                    for (int n = 0; n < 2; ++n) { const f32x4 v = acc[ai][bj][m][n] * rk; u32x2 w; w.x = cvt_pk_bf16(v[0], v[1]); w.y = cvt_pk_bf16(v[2], v[3]); *(u32x2*)(dst + 16 * n) = w; } } }
    }
};
struct EpiPw {
    static constexpr bool PERM = true, AFTER_DRAIN = false;
    bf16_t* mix; const bf16_t* z; const float* bpw;
    __device__ __forceinline__ void operator()(const f32x4 (&acc)[2][2][4][2], const Unit& u, int wr, int wc, int fr, int fq) const {
        asm volatile("" : "+v"(fr), "+v"(fq), "+s"(wr), "+s"(wc));
        const int col0 = u.pn * BM + wc * 32 + 8 * fq;
        f32x4 bv[2][2];
#pragma unroll
        for (int bj = 0; bj < 2; ++bj)
#pragma unroll
            for (int n = 0; n < 2; ++n) bv[bj][n] = *(const f32x4*)(bpw + col0 + bj * HALF + 4 * n);
#pragma unroll
        for (int ai = 0; ai < 2; ++ai)
#pragma unroll
            for (int m = 0; m < 4; ++m) { const size_t t = (size_t)(u.pm * BM + ai * HALF + wr * 64 + m * 16 + fr);
#pragma unroll
                for (int bj = 0; bj < 2; ++bj) { const int c = col0 + bj * HALF; const u32x4 gz = __builtin_nontemporal_load((const u32x4*)(z + t * INC + Z_CG + c));
                    const f32x4 v0 = acc[ai][bj][m][0] + bv[bj][0], v1 = acc[ai][bj][m][1] + bv[bj][1];
                    u32x4 w; w.x = cvt_pk_bf16(v0[0] * fast_silu(bf_lo(gz.x)), v0[1] * fast_silu(bf_hi(gz.x))); w.y = cvt_pk_bf16(v0[2] * fast_silu(bf_lo(gz.y)), v0[3] * fast_silu(bf_hi(gz.y)));
                    w.z = cvt_pk_bf16(v1[0] * fast_silu(bf_lo(gz.z)), v1[1] * fast_silu(bf_hi(gz.z))); w.w = cvt_pk_bf16(v1[2] * fast_silu(bf_lo(gz.w)), v1[3] * fast_silu(bf_hi(gz.w)));
                    *(u32x4*)(mix + t * DM + DC + c) = w; }
                if (m & 1) asm volatile("" ::: "memory"); }
    }
};
struct EpiOut {
    static constexpr bool PERM = true, AFTER_DRAIN = false;
    const float* xin; float* xout; const float* gate;
    __device__ __forceinline__ void operator()(const f32x4 (&acc)[2][2][4][2], const Unit& u, int wr, int wc, int fr, int fq) const {
        asm volatile("" : "+v"(fr), "+v"(fq), "+s"(wr), "+s"(wc));
        const int col0 = u.pn * BM + wc * 32 + 8 * fq; const int b = (u.pm * BM) / SEQ;
        f32x4 gv[2][2];
#pragma unroll
        for (int bj = 0; bj < 2; ++bj)
#pragma unroll
            for (int n = 0; n < 2; ++n) gv[bj][n] = *(const f32x4*)(gate + (size_t)b * 6144 + col0 + bj * HALF + 4 * n);
#pragma unroll
        for (int ai = 0; ai < 2; ++ai)
#pragma unroll
            for (int m = 0; m < 4; ++m) { const size_t off = (size_t)(u.pm * BM + ai * HALF + wr * 64 + m * 16 + fr) * DM + col0;
#pragma unroll
                for (int bj = 0; bj < 2; ++bj)
#pragma unroll
                    for (int n = 0; n < 2; ++n) { const f32x4 xv = __builtin_nontemporal_load((const f32x4*)(xin + off + bj * HALF + 4 * n));
                        *(f32x4*)(xout + off + bj * HALF + 4 * n) = xv + gv[bj][n] * acc[ai][bj][m][n]; }
                if (m == 3) asm volatile("" ::: "memory"); }
    }
};
struct EpiHead {
    static constexpr bool PERM = true, AFTER_DRAIN = false;
    bf16_t* O; const float* g; const float* cs; const float* sn; PG8_LAS float* P; const float* ssq; int qmode;
    __device__ __forceinline__ void operator()(const f32x4 (&acc)[2][2][4][2], const Unit& u, int wr, int wc, int fr, int fq) const {
        asm volatile("" : "+v"(fr), "+v"(fq), "+s"(wr), "+s"(wc));
        float rl8[2][4];
#pragma unroll
        for (int ai = 0; ai < 2; ++ai)
#pragma unroll
            for (int m = 0; m < 4; ++m) { const float* sp = ssq + (size_t)(u.pm * BM + ai * HALF + wr * 64 + m * 16 + fr) * 12; float lat;
                if (qmode) { const f32x4 a4 = *(const f32x4*)sp, b4 = *(const f32x4*)(sp + 4); lat = (((a4[0] + a4[1]) + (a4[2] + a4[3])) + ((b4[0] + b4[1]) + (b4[2] + b4[3]))) * (1.0f / 512.0f); }
                else { const f32x4 a4 = *(const f32x4*)(sp + 8); lat = ((a4[0] + a4[1]) + (a4[2] + a4[3])) * (1.0f / 256.0f); }
                rl8[ai][m] = __builtin_amdgcn_rsqf(lat + 1e-6f); }
#pragma unroll
        for (int ai = 0; ai < 2; ++ai)
#pragma unroll
            for (int m = 0; m < 4; ++m) { float s0 = 0.f, s1 = 0.f;
#pragma unroll
                for (int n = 0; n < 2; ++n) { const f32x4 x = acc[ai][0][m][n], y = acc[ai][1][m][n];
                    s0 += (x[0] * x[0] + x[1] * x[1]) + (x[2] * x[2] + x[3] * x[3]); s1 += (y[0] * y[0] + y[1] * y[1]) + (y[2] * y[2] + y[3] * y[3]); }
                s0 += xshfl<16>(s0); s0 = xsum32(s0); s1 += xshfl<16>(s1); s1 = xsum32(s1);
                if (fq == 0) { PG8_LAS float* pp = P + ((ai * HALF + wr * 64 + m * 16 + fr) * 4 + wc) * 2; pp[0] = s0; pp[1] = s1; } }
        asm volatile("s_waitcnt lgkmcnt(0)" ::: "memory"); __builtin_amdgcn_s_barrier(); asm volatile("" ::: "memory");
        const int t0 = u.pm * BM, b = t0 / SEQ, s0r = t0 % SEQ, h = u.pn, e = 16 * wc + 4 * fq;
        f32x4 g0[2], g1 = {0.f, 0.f, 0.f, 0.f}, g2 = {0.f, 0.f, 0.f, 0.f};
#pragma unroll
        for (int n = 0; n < 2; ++n) g0[n] = *(const f32x4*)(g + wc * 32 + 8 * fq + 4 * n);
        if (wc < 2) { g1 = *(const f32x4*)(g + 128 + e); g2 = *(const f32x4*)(g + 160 + e); }
#pragma unroll
        for (int ai = 0; ai < 2; ++ai)
#pragma unroll
            for (int m = 0; m < 4; ++m) { const int r = ai * HALF + wr * 64 + m * 16 + fr;
                const f32x4 pa = *(const PG8_LAS f32x4*)(P + r * 8), pb = *(const PG8_LAS f32x4*)(P + r * 8 + 4);
                const float S0 = (pa[0] + pa[2]) + (pb[0] + pb[2]), S1 = (pa[1] + pa[3]) + (pb[1] + pb[3]);
                const float rl = rl8[ai][m], rr = qmode ? rl : 1.0f;
                const float f = __builtin_amdgcn_rsqf((rl * rl * S0 + rr * rr * S1) * (1.0f / 192.0f) + 1e-6f), fn = rl * f, fp = rr * f;
                bf16_t* dst = O + ((size_t)((b * NH + h) * SEQ + s0r + r)) * QKD;
                { const f32x4 v0 = acc[ai][0][m][0] * fn * g0[0], v1 = acc[ai][0][m][1] * fn * g0[1]; u32x4 w; w.x = cvt_pk_bf16(v0[0], v0[1]); w.y = cvt_pk_bf16(v0[2], v0[3]); w.z = cvt_pk_bf16(v1[0], v1[1]); w.w = cvt_pk_bf16(v1[2], v1[3]); *(u32x4*)(dst + wc * 32 + 8 * fq) = w; }
                if (wc < 2) { const size_t tt = (size_t)(t0 + r) * 32 + e; const f32x4 c4 = *(const f32x4*)(cs + tt), s4 = *(const f32x4*)(sn + tt);
                    const f32x4 x1 = acc[ai][1][m][0] * fp * g1, x2 = acc[ai][1][m][1] * fp * g2; const f32x4 o1 = x1 * c4 - x2 * s4, o2 = x2 * c4 + x1 * s4;
                    u32x2 w1, w2; w1.x = cvt_pk_bf16(o1[0], o1[1]); w1.y = cvt_pk_bf16(o1[2], o1[3]); w2.x = cvt_pk_bf16(o2[0], o2[1]); w2.y = cvt_pk_bf16(o2[2], o2[3]);
                    *(u32x2*)(dst + 128 + e) = w1; *(u32x2*)(dst + 160 + e) = w2; }
                if (m & 1) asm volatile("" ::: "memory"); }
    }
};
template <class Epi, class Sched, bool ALIGN_EPI = false, bool SP2 = false>
__device__ __forceinline__ void gemm_phase(PG8_LAS unsigned char* lds, const Gemm g, const Sched& S, const Epi& E) {
    int tid_ = threadIdx.x; asm volatile("" : "+v"(tid_));
    const int tid = tid_, wid = __builtin_amdgcn_readfirstlane(tid >> 6), lane = tid & 63, wr = wid >> 2, wc = wid & 3, fr = lane & 15, fq = lane >> 4;
    const int K = g.K, nt = K / BK;
    unsigned voffA[2], voffB[2];
#pragma unroll
    for (int i = 0; i < 2; ++i) { int R, C; stage_rc(tid * 16 + i * 8192, R, C); const int Rb = Epi::PERM ? ((R & ~31) + perm32(R & 31)) : R;
        voffA[i] = (unsigned)(R * g.lda + C) * 2u; voffB[i] = (unsigned)(Rb * g.ldb + C) * 2u; }
    const size_t kstep = (size_t)(BK * 2);
    const size_t hstepA = (size_t)HALF * g.lda * 2, hstepB = (size_t)HALF * g.ldb * 2;
    const size_t tstepA = 2 * hstepA, tstepB = 2 * hstepB;
    const unsigned ldsw = (unsigned)wid * 1024u;
    const int aoff = lds_byte(wr * 64 + fr, fq * 8), boff = lds_byte(wc * 32 + fr, fq * 8);
#define PG8_SA(b, h) (((b) * 2 + (h)) * HTB)
#define PG8_SB(b, h) ((4 + (b) * 2 + (h)) * HTB)
#define PG8_STAGE(bufoff, gbase, voff) do { _Pragma("unroll") for (int _i = 0; _i < 2; ++_i) \
        __builtin_amdgcn_global_load_lds((const unsigned*)((const char*)(gbase) + (voff)[_i]), (PG8_LAS unsigned*)(lds + (bufoff) + ldsw + _i * 8192), 16, 0, 0); } while (0)
#define PG8_LDA(dst, b, h) do { _Pragma("unroll") for (int m = 0; m < 4; ++m) _Pragma("unroll") for (int k = 0; k < 2; ++k) dst[m][k] = *(const PG8_LAS bf16x8*)(lds + PG8_SA(b, h) + aoff + m * 2048 + k * 1024); } while (0)
#define PG8_LDB(dst, b, h) do { _Pragma("unroll") for (int n = 0; n < 2; ++n) _Pragma("unroll") for (int k = 0; k < 2; ++k) dst[n][k] = *(const PG8_LAS bf16x8*)(lds + PG8_SB(b, h) + boff + n * 2048 + k * 1024); } while (0)
#define PG8_MMA(ai, bj, At, Bt) do { __builtin_amdgcn_s_setprio(1); _Pragma("unroll") for (int m = 0; m < 4; ++m) _Pragma("unroll") for (int n = 0; n < 2; ++n) _Pragma("unroll") for (int k = 0; k < 2; ++k) \
        acc[ai][bj][m][n] = __builtin_amdgcn_mfma_f32_16x16x32_bf16(Bt[n][k], At[m][k], acc[ai][bj][m][n], 0, 0, 0); __builtin_amdgcn_s_setprio(0); } while (0)
#define PG8_WAIT_V(n) asm volatile("s_waitcnt vmcnt(" #n ")" ::: "memory")
#define PG8_WAIT_L(n) asm volatile("s_waitcnt lgkmcnt(" #n ")" ::: "memory")
#define PG8_BAR __builtin_amdgcn_s_barrier()
#define PG8_SCHED __builtin_amdgcn_sched_barrier(0)
    Unit cur, nxt; int ui = 0;
    if (!S.next(0, cur)) return;
    f32x4 acc[2][2][4][2];
#pragma unroll
    for (int a = 0; a < 2; ++a)
#pragma unroll
        for (int b = 0; b < 2; ++b)
#pragma unroll
            for (int m = 0; m < 4; ++m)
#pragma unroll
                for (int n = 0; n < 2; ++n) acc[a][b][m][n] = (f32x4){0.f, 0.f, 0.f, 0.f};
    bf16x8 At[4][2], B0[2][2], B1[2][2];
    const char* cA = (const char*)g.A + (size_t)cur.pm * tstepA; const char* cB = (const char*)g.Bt + (size_t)cur.pn * tstepB;
    S.a_ready(cur);
    if constexpr (SP2) {
        PG8_STAGE(PG8_SB(0, 0), cB, voffB); PG8_STAGE(PG8_SB(0, 1), cB + hstepB, voffB); PG8_STAGE(PG8_SA(0, 0), cA, voffA); PG8_STAGE(PG8_SA(0, 1), cA + hstepA, voffA);
        if (wr == 1) PG8_BAR;
        PG8_WAIT_V(2); PG8_BAR;
        PG8_STAGE(PG8_SB(1, 0), cB + kstep, voffB); PG8_STAGE(PG8_SA(1, 0), cA + kstep, voffA); PG8_STAGE(PG8_SB(1, 1), cB + hstepB + kstep, voffB);
        PG8_WAIT_V(6); PG8_BAR;
    } else {
        PG8_STAGE(PG8_SB(0, 0), cB, voffB); PG8_STAGE(PG8_SA(0, 0), cA, voffA); PG8_STAGE(PG8_SB(0, 1), cB + hstepB, voffB); PG8_STAGE(PG8_SA(0, 1), cA + hstepA, voffA);
        if (wr == 1) PG8_BAR;
        PG8_WAIT_V(4); PG8_BAR;
        PG8_STAGE(PG8_SB(1, 0), cB + kstep, voffB); PG8_STAGE(PG8_SA(1, 0), cA + kstep, voffA); PG8_STAGE(PG8_SB(1, 1), cB + hstepB + kstep, voffB);
        PG8_WAIT_V(6); PG8_BAR;
    }
    for (;;) {
        const bool has_next = S.next(ui + 1, nxt);
        const char* nA = has_next ? (const char*)g.A + (size_t)nxt.pm * tstepA : cA; const char* nB = has_next ? (const char*)g.Bt + (size_t)nxt.pn * tstepB : cB;
        for (int t = 0; t < nt; t += 2) {
            const bool last = (t == nt - 2);
            const char* a1 = cA + (size_t)(t + 1) * kstep;
            const char* a2 = last ? nA : cA + (size_t)(t + 2) * kstep; const char* b2 = last ? nB : cB + (size_t)(t + 2) * kstep;
            const char* a3 = a2 + kstep; const char* b3 = b2 + kstep;
            if (last && has_next) S.a_ready(nxt);
            if constexpr (SP2) {
            PG8_LDB(B0, 0, 0); PG8_LDB(B1, 0, 1); PG8_SCHED; PG8_LDA(At, 0, 0); PG8_STAGE(PG8_SA(1, 1), a1 + hstepA, voffA);
            PG8_WAIT_V(8); PG8_WAIT_L(0); PG8_BAR; PG8_MMA(0, 0, At, B0); PG8_MMA(0, 1, At, B1); PG8_BAR; PG8_SCHED;
            PG8_LDA(At, 0, 1); PG8_STAGE(PG8_SB(0, 0), b2, voffB); PG8_STAGE(PG8_SB(0, 1), b2 + hstepB, voffB); PG8_STAGE(PG8_SA(0, 0), a2, voffA);
            PG8_WAIT_V(8); PG8_WAIT_L(0); PG8_BAR; PG8_MMA(1, 0, At, B0); PG8_MMA(1, 1, At, B1); PG8_BAR; PG8_SCHED;
            PG8_LDB(B0, 1, 0); PG8_LDB(B1, 1, 1); PG8_SCHED; PG8_LDA(At, 1, 0); PG8_STAGE(PG8_SA(0, 1), a2 + hstepA, voffA);
            PG8_WAIT_V(8); PG8_WAIT_L(0); PG8_BAR; PG8_MMA(0, 0, At, B0); PG8_MMA(0, 1, At, B1); PG8_BAR; PG8_SCHED;
            PG8_LDA(At, 1, 1); PG8_STAGE(PG8_SB(1, 0), b3, voffB); PG8_STAGE(PG8_SB(1, 1), b3 + hstepB, voffB); PG8_STAGE(PG8_SA(1, 0), a3, voffA);
            PG8_WAIT_V(8); PG8_WAIT_L(0); PG8_BAR; PG8_MMA(1, 0, At, B0); PG8_MMA(1, 1, At, B1); PG8_BAR; PG8_SCHED;
            } else {
            PG8_LDB(B0, 0, 0); PG8_SCHED; PG8_LDA(At, 0, 0); PG8_STAGE(PG8_SA(1, 1), a1 + hstepA, voffA);
            PG8_WAIT_L(8); PG8_BAR; PG8_WAIT_L(0); PG8_MMA(0, 0, At, B0); PG8_BAR; PG8_SCHED;
            PG8_LDB(B1, 0, 1); PG8_STAGE(PG8_SB(0, 0), b2, voffB);
            PG8_BAR; PG8_WAIT_L(0); PG8_MMA(0, 1, At, B1); PG8_BAR;
            PG8_LDA(At, 0, 1); PG8_STAGE(PG8_SA(0, 0), a2, voffA);
            PG8_BAR; PG8_WAIT_L(0); PG8_MMA(1, 0, At, B0); PG8_BAR; PG8_SCHED;
            PG8_STAGE(PG8_SB(0, 1), b2 + hstepB, voffB);
            PG8_WAIT_V(6); PG8_BAR; PG8_MMA(1, 1, At, B1); PG8_BAR;
            PG8_LDB(B0, 1, 0); PG8_SCHED; PG8_LDA(At, 1, 0); PG8_STAGE(PG8_SA(0, 1), a2 + hstepA, voffA);
            PG8_WAIT_L(8); PG8_BAR; PG8_WAIT_L(0); PG8_MMA(0, 0, At, B0); PG8_BAR; PG8_SCHED;
            PG8_LDB(B1, 1, 1); PG8_STAGE(PG8_SB(1, 0), b3, voffB);
            PG8_BAR; PG8_WAIT_L(0); PG8_MMA(0, 1, At, B1); PG8_BAR;
            PG8_LDA(At, 1, 1); PG8_STAGE(PG8_SA(1, 0), a3, voffA);
            PG8_BAR; PG8_WAIT_L(0); PG8_MMA(1, 0, At, B0); PG8_BAR; PG8_SCHED;
            PG8_STAGE(PG8_SB(1, 1), b3 + hstepB, voffB);
            PG8_WAIT_V(6); PG8_BAR; PG8_MMA(1, 1, At, B1); PG8_BAR;
            }
        }
        if constexpr (ALIGN_EPI) { if (wr == 0) PG8_BAR; }
        if constexpr (!Epi::AFTER_DRAIN) { int t2_ = threadIdx.x; asm volatile("" : "+v"(t2_)); E(acc, cur, wr, wc, t2_ & 15, (t2_ & 63) >> 4); S.done(cur); }
        if (!has_next) break;
#pragma unroll
        for (int a = 0; a < 2; ++a)
#pragma unroll
            for (int b = 0; b < 2; ++b)
#pragma unroll
                for (int m = 0; m < 4; ++m)
#pragma unroll
                    for (int n = 0; n < 2; ++n) acc[a][b][m][n] = (f32x4){0.f, 0.f, 0.f, 0.f};
        cur = nxt; cA = nA; cB = nB; ++ui;
        if constexpr (ALIGN_EPI) { if (wr == 1) PG8_BAR; }
    }
    PG8_WAIT_V(0);
    if constexpr (!ALIGN_EPI) { if (wr == 0) PG8_BAR; }
    PG8_BAR;
    if constexpr (Epi::AFTER_DRAIN) { E.fused(acc, cur, wr, wc, fr, fq, lds, wid, lane); S.done(cur); }
#undef PG8_SA
#undef PG8_SB
#undef PG8_STAGE
#undef PG8_LDA
#undef PG8_LDB
#undef PG8_MMA
#undef PG8_WAIT_V
#undef PG8_WAIT_L
#undef PG8_BAR
#undef PG8_SCHED
}
}
namespace att {
#define ALAS __attribute__((address_space(3)))
typedef unsigned short bf16_t;
typedef short bf16x8 __attribute__((ext_vector_type(8)));
typedef short s16x4 __attribute__((ext_vector_type(4)));
typedef float f32x16 __attribute__((ext_vector_type(16)));
typedef float f32x4 __attribute__((ext_vector_type(4)));
typedef unsigned u32x4 __attribute__((ext_vector_type(4)));
constexpr int NW = 8, QBLK = 32, KVBLK = 64, QB = 256;
constexpr int KROW = 400;
constexpr int SHM_V = KVBLK * VD * 2, SHM_K = KVBLK * KROW;
constexpr int LDS_V = 0, LDS_K = 2 * SHM_V, LDS_WS = LDS_K + 2 * SHM_K, LDS_BYTES = LDS_WS + NW * 64 * 4;
constexpr float SCALE = 0.07216878364870323f;
constexpr float THR = 8.f;
#define SBAR() __builtin_amdgcn_sched_barrier(0)
__device__ __forceinline__ int v_st(int k, int c) { const int kk = (k & ~0xC) | ((k & 4) << 1) | ((k & 8) >> 1); return ((kk >> 3) * 4 + (c >> 5)) * 512 + ((kk & 7) * 32 + (c & 31)) * 2; }
__device__ __forceinline__ int v_rd_base(int lane) { return ((lane & 3) << 3) | (((lane >> 2) & 3) << 6) | (((lane >> 4) & 1) << 5) | (((lane >> 5) & 1) << 8); }
constexpr int v_rd_off(int d0, int ks, int half) { return d0 * 512 + ks * 4096 + half * 2048; }
__device__ __forceinline__ int crow(int r, int hi) { return (r & 3) + 8 * (r >> 2) + 4 * hi; }
__device__ __forceinline__ unsigned cvtpk(float lo, float hi) { unsigned r; asm volatile("v_cvt_pk_bf16_f32 %0, %1, %2" : "=v"(r) : "v"(lo), "v"(hi)); return r; }
__device__ __forceinline__ void mask_tile(f32x16& p0, f32x16& p1, int dq) {
    const float NEG = -__builtin_inff();
#pragma unroll
    for (int r = 0; r < 16; ++r) { const int c = (r & 3) + 8 * (r >> 2); if (dq - c < 0) p0[r] = NEG; if (dq - c - 32 < 0) p1[r] = NEG; }
}
__device__ __forceinline__ void partialSM(f32x16& p0, f32x16& p1, float& m_reg, float& mn, float& alpha) {
    float pmax = p0[0];
#pragma unroll
    for (int r = 1; r < 16; ++r) pmax = fmaxf(pmax, p0[r]);
#pragma unroll
    for (int r = 0; r < 16; ++r) pmax = fmaxf(pmax, p1[r]);
    { auto rr = __builtin_amdgcn_permlane32_swap(__float_as_uint(pmax), __float_as_uint(pmax), false, false); pmax = fmaxf(__uint_as_float(rr[0]), __uint_as_float(rr[1])); }
    constexpr float C2 = 1.4426950408889634f * SCALE;
    if (__builtin_expect(__all((pmax - m_reg) * SCALE <= THR), 1)) { mn = m_reg; alpha = 1.f; }
    else { mn = fmaxf(m_reg, pmax); alpha = __builtin_amdgcn_exp2f((m_reg - mn) * C2); m_reg = mn; }
    const float mnL = -mn * C2;
#pragma unroll
    for (int r = 0; r < 16; ++r) p0[r] = fmaf(p0[r], C2, mnL);
#pragma unroll
    for (int r = 0; r < 16; ++r) p1[r] = fmaf(p1[r], C2, mnL);
#pragma unroll
    for (int r = 0; r < 16; ++r) p0[r] = __builtin_amdgcn_exp2f(p0[r]);
}
__device__ __forceinline__ void finishSM(f32x16& p0, f32x16& p1, float alpha, float& l_reg, bf16x8& pa0, bf16x8& pa1, bf16x8& pa2, bf16x8& pa3) {
#pragma unroll
    for (int r = 0; r < 16; ++r) p1[r] = __builtin_amdgcn_exp2f(p1[r]);
    float ps = 0;
#pragma unroll
    for (int r = 0; r < 16; ++r) ps += p0[r];
#pragma unroll
    for (int r = 0; r < 16; ++r) ps += p1[r];
    { auto rr = __builtin_amdgcn_permlane32_swap(__float_as_uint(ps), __float_as_uint(ps), false, false); ps = __uint_as_float(rr[0]) + __uint_as_float(rr[1]); }
    l_reg = l_reg * alpha + ps;
#define PK4(P, B_, OUT) do { unsigned a0 = cvtpk(P[B_+0], P[B_+1]), a1 = cvtpk(P[B_+2], P[B_+3]);                          \
        unsigned b0 = cvtpk(P[B_+4], P[B_+5]), b1 = cvtpk(P[B_+6], P[B_+7]);                                             \
        auto r0 = __builtin_amdgcn_permlane32_swap(a0, b0, false, false); auto r1 = __builtin_amdgcn_permlane32_swap(a1, b1, false, false); \
        u32x4 w = {r0[0], r1[0], r0[1], r1[1]}; OUT = *reinterpret_cast<bf16x8*>(&w); } while (0)
    PK4(p0, 0, pa0); PK4(p0, 8, pa1); PK4(p1, 0, pa2); PK4(p1, 8, pa3);
#undef PK4
}
#ifndef QK_DEPTH
#define QK_DEPTH 6
#endif
template <int KB>
__device__ __forceinline__ void qkt(f32x16& p0, f32x16& p1, const ALAS char* kb, const bf16x8* qr) {
    p0 = f32x16{}; p1 = f32x16{};
#define KRD(f) (*(const ALAS bf16x8*)(kb + KB * SHM_K + ((f) >> 1) * 32 + ((f) & 1) * 32 * KROW))
    bf16x8 kf[QK_DEPTH];
#pragma unroll
    for (int f = 0; f < QK_DEPTH; ++f) kf[f] = KRD(f);
    SBAR();
#pragma unroll
    for (int f = 0; f < 24; ++f) {
        if (f & 1) p1 = __builtin_amdgcn_mfma_f32_32x32x16_bf16(kf[f % QK_DEPTH], qr[f >> 1], p1, 0, 0, 0);
        else       p0 = __builtin_amdgcn_mfma_f32_32x32x16_bf16(kf[f % QK_DEPTH], qr[f >> 1], p0, 0, 0, 0);
        if (f + QK_DEPTH < 24) kf[f % QK_DEPTH] = KRD(f + QK_DEPTH);
        SBAR();
    }
#undef KRD
}
template <int VB>
__device__ __forceinline__ void pv_tile(f32x16* o, int vb0, bf16x8 pa0, bf16x8 pa1, bf16x8 pa2, bf16x8 pa3) {
#define TRRD(dst, off) asm volatile("ds_read_b64_tr_b16 %0, %1 offset:%2" : "=&v"(dst) : "v"(vb0), "i"(off) : "memory")
#define PV_D0(d0) do { s16x4 l0, l1, l2, l3, h0, h1, h2, h3; constexpr int b_ = VB * SHM_V + v_rd_off(d0, 0, 0); \
        TRRD(l0, b_); TRRD(h0, b_ + 2048); TRRD(l1, b_ + 4096); TRRD(h1, b_ + 6144); TRRD(l2, b_ + 8192); TRRD(h2, b_ + 10240); TRRD(l3, b_ + 12288); TRRD(h3, b_ + 14336); \
        asm volatile("s_waitcnt lgkmcnt(0)" ::: "memory"); SBAR(); \
        o[d0] = __builtin_amdgcn_mfma_f32_32x32x16_bf16(pa0, (bf16x8){l0[0], l0[1], l0[2], l0[3], h0[0], h0[1], h0[2], h0[3]}, o[d0], 0, 0, 0);   \
        o[d0] = __builtin_amdgcn_mfma_f32_32x32x16_bf16(pa1, (bf16x8){l1[0], l1[1], l1[2], l1[3], h1[0], h1[1], h1[2], h1[3]}, o[d0], 0, 0, 0);   \
        o[d0] = __builtin_amdgcn_mfma_f32_32x32x16_bf16(pa2, (bf16x8){l2[0], l2[1], l2[2], l2[3], h2[0], h2[1], h2[2], h2[3]}, o[d0], 0, 0, 0);   \
        o[d0] = __builtin_amdgcn_mfma_f32_32x32x16_bf16(pa3, (bf16x8){l3[0], l3[1], l3[2], l3[3], h3[0], h3[1], h3[2], h3[3]}, o[d0], 0, 0, 0); } while (0)
    PV_D0(0); PV_D0(1); PV_D0(2); PV_D0(3);
#undef PV_D0
#undef TRRD
}
__device__ __forceinline__ float silu_f(float v) { return v * __builtin_amdgcn_rcpf(1.0f + __builtin_amdgcn_exp2f(-1.4426950408889634f * v)); }

__device__ __forceinline__ void attn_block(const bf16_t* __restrict__ Qh, const bf16_t* __restrict__ Kh, const bf16_t* __restrict__ Vh, int qb,
                                           bf16_t* __restrict__ mixp, const bf16_t* __restrict__ zg, ALAS char* lds) {
    int tid_ = threadIdx.x; asm volatile("" : "+v"(tid_));
    const int tid = tid_, wid = __builtin_amdgcn_readfirstlane(tid >> 6), lane = tid & 63, r32 = lane & 31, hi = lane >> 5;
    const int NT = 4 * (qb + 1);
    const int qlo = qb * QB + wid * QBLK, qm = qlo + r32 - 4 * hi;
    ALAS char* V_lds = lds + LDS_V; ALAS char* K_lds = lds + LDS_K;
    ALAS float* ws = (ALAS float*)(lds + LDS_WS) + wid * 64; ALAS float* li_l = ws; ALAS float* al_l = ws + 32;
    float m_reg = -1e30f, l_reg = 0; f32x16 o[4] = {};
    const int sr = tid >> 4, sc = (tid & 15) * 8, vst0 = v_st(sr, sc), vst1 = v_st(32 + sr, sc);
    int kld[3];
#pragma unroll
    for (int i = 0; i < 3; ++i) { const int ci = tid + 512 * i; kld[i] = (ci / 24) * KROW + (ci % 24) * 16; }
    const int vb0 = (int)(unsigned)(uintptr_t)V_lds + v_rd_base(lane);
    const ALAS char* kb = K_lds + r32 * KROW + hi * 16;
    bf16x8 qr[12];
#pragma unroll
    for (int d0 = 0; d0 < 12; ++d0) qr[d0] = *(const bf16x8*)((const char*)Qh + (unsigned)(((qlo + r32) * QKD + d0 * 16 + hi * 8) * 2));
    bf16x8 st_v0, st_v1, st_k0, st_k1, st_k2;
    const unsigned vof0 = (unsigned)((sr * VD + sc) * 2), vof1 = vof0 + 32 * VD * 2, kof0 = (unsigned)tid * 16u, kof1 = kof0 + 8192u, kof2 = kof0 + 16384u;
#define SLOAD(t) do { const char* vt_ = (const char*)Vh + (size_t)(t) * (KVBLK * VD * 2); const char* kt_ = (const char*)Kh + (size_t)(t) * (KVBLK * QKD * 2); \
        st_v0 = *(const bf16x8*)(vt_ + vof0); st_v1 = *(const bf16x8*)(vt_ + vof1); st_k0 = *(const bf16x8*)(kt_ + kof0); st_k1 = *(const bf16x8*)(kt_ + kof1); st_k2 = *(const bf16x8*)(kt_ + kof2); } while (0)
#define SWRITE(bf) do { *(ALAS bf16x8*)(V_lds + (bf) * SHM_V + vst0) = st_v0; *(ALAS bf16x8*)(V_lds + (bf) * SHM_V + vst1) = st_v1; \
        *(ALAS bf16x8*)(K_lds + (bf) * SHM_K + kld[0]) = st_k0; *(ALAS bf16x8*)(K_lds + (bf) * SHM_K + kld[1]) = st_k1; *(ALAS bf16x8*)(K_lds + (bf) * SHM_K + kld[2]) = st_k2; } while (0)
#define RESC(a) do { if (__any((a) < 1.f)) { if (hi == 0) al_l[r32] = (a); asm volatile("s_waitcnt lgkmcnt(0)" ::: "memory");              \
                     _Pragma("unroll") for (int d_ = 0; d_ < 4; ++d_) _Pragma("unroll") for (int r = 0; r < 16; ++r) o[d_][r] *= al_l[crow(r, hi)]; } } while (0)
#define MASKT(P0_, P1_, t) do { const int kb_ = (t) * KVBLK; if (kb_ + KVBLK - 1 > qlo) mask_tile(P0_, P1_, qm - kb_); } while (0)
    f32x16 p0, p1; float mn, al; bf16x8 pa0, pa1, pa2, pa3;
    SLOAD(0); SWRITE(0); SLOAD(1);
    __syncthreads();
#define STEP(t, KB) do { if ((t) + 1 < NT) { SWRITE(1 - KB); } if ((t) + 2 < NT) { SLOAD((t) + 2); } SBAR();            \
        qkt<KB>(p0, p1, kb, qr); MASKT(p0, p1, (t)); partialSM(p0, p1, m_reg, mn, al); RESC(al);                       \
        finishSM(p0, p1, al, l_reg, pa0, pa1, pa2, pa3); SBAR(); pv_tile<KB>(o, vb0, pa0, pa1, pa2, pa3);               \
        __syncthreads(); } while (0)
    for (int t = 0; t < NT; t += 2) { STEP(t, 0); STEP(t + 1, 1); }
#undef STEP
    if (hi == 0) li_l[r32] = l_reg; asm volatile("s_waitcnt lgkmcnt(0)" ::: "memory");
    { int le = lane; asm volatile("" : "+v"(le));
      const int r32e = le & 31, hie = le >> 5;
      ALAS char* stg = lds + wid * 8192;
#pragma unroll
      for (int r = 0; r < 16; ++r) { const int orow = crow(r, hie); const float rl = __builtin_amdgcn_rcpf(li_l[orow]);
#pragma unroll
          for (int d0 = 0; d0 < 4; ++d0) { const float v = o[d0][r] * rl; const float vn = xshfl<1>(v);
              if ((r32e & 1) == 0) *(ALAS unsigned*)(stg + orow * 256 + (d0 * 32 + r32e) * 2) = cvtpk(v, vn); } }
      asm volatile("s_waitcnt lgkmcnt(0)" ::: "memory");
#pragma unroll
      for (int i = 0; i < 8; ++i) { const int c = le + 64 * i, row = c >> 4, ch = c & 15;
          const u32x4 ov = *(const ALAS u32x4*)(stg + row * 256 + ch * 16);
          const u32x4 gz = __builtin_nontemporal_load((const u32x4*)((const char*)zg + (unsigned)(((qlo + row) * INC + ch * 8) * 2)));
#define GM(O_, G_) cvtpk(__uint_as_float((O_) << 16) * silu_f(__uint_as_float((G_) << 16)), __uint_as_float((O_) & 0xffff0000u) * silu_f(__uint_as_float((G_) & 0xffff0000u)))
          u32x4 w; w.x = GM(ov.x, gz.x); w.y = GM(ov.y, gz.y); w.z = GM(ov.z, gz.z); w.w = GM(ov.w, gz.w);
#undef GM
          *(u32x4*)((char*)mixp + (unsigned)(((qlo + row) * DM + ch * 8) * 2)) = w; } }
    __syncthreads();
#undef SLOAD
#undef SWRITE
#undef RESC
#undef MASKT
}
#undef SBAR
}
#define LAS __attribute__((address_space(3)))
#define CAS __attribute__((address_space(4)))
typedef unsigned short bf16_t;
typedef float f32x4 __attribute__((ext_vector_type(4)));
typedef float f32x2 __attribute__((ext_vector_type(2)));
typedef unsigned u32x4 __attribute__((ext_vector_type(4)));
typedef unsigned u32x2 __attribute__((ext_vector_type(2)));
using pg8::cvt_pk_bf16; using pg8::bf_lo; using pg8::bf_hi; using pg8::fast_silu;

constexpr int NWAVES = 8, NTHREADS = 512;
constexpr int RING_BYTES = 131072, EXCH_OFF = RING_BYTES, BST_OFF = EXCH_OFF + 8192, LDS_BYTES = BST_OFF + 64;
constexpr int PH_PER_LAYER = 5, N_PHASES = 1 + PH_PER_LAYER * DEPTH;
#ifndef EN_P0
#define EN_P0 1
#endif
#ifndef EN_A
#define EN_A 1
#endif
#ifndef EN_B
#define EN_B 1
#endif
#ifndef EN_C1
#define EN_C1 1
#endif
#ifndef EN_C2
#define EN_C2 1
#endif
#ifndef EN_D
#define EN_D 1
#endif
#ifndef EN_E
#define EN_E 1
#endif
#ifndef EN_ATT
#define EN_ATT 1
#endif
#ifndef EN_PW
#define EN_PW 1
#endif
#ifndef REP_P0
#define REP_P0 1
#endif
#ifndef REP_A
#define REP_A 1
#endif
#ifndef REP_B
#define REP_B 1
#endif
#ifndef REP_C1
#define REP_C1 1
#endif
#ifndef REP_C2
#define REP_C2 1
#endif
#ifndef REP_ATT
#define REP_ATT 1
#endif
#ifndef REP_PW
#define REP_PW 1
#endif
#ifndef REP_E0
#define REP_E0 1
#endif
#ifndef REP_LAT
#define REP_LAT 1
#endif
#ifndef REP_CONV
#define REP_CONV 1
#endif
#ifndef REP_GEMV
#define REP_GEMV 1
#endif
#ifndef REP_CVT
#define REP_CVT 1
#endif
#ifndef WGM_B
#define WGM_B 5
#endif
#ifndef WGM_E
#define WGM_E 2
#endif
#ifndef WGM_QK
#define WGM_QK 8
#endif
#ifndef WGM_V
#define WGM_V 4
#endif
#ifndef WGM_PW
#define WGM_PW 4
#endif
#ifndef MK_ONE_LAUNCH
#define MK_ONE_LAUNCH 1
#endif

constexpr size_t MiB = 1u << 20;
constexpr size_t WS_MOD = 1 * MiB;
constexpr size_t WS_BIAS = WS_MOD + 256 * 1024;
constexpr size_t WS_COS = 2 * MiB, WS_SIN = 4 * MiB;
constexpr size_t WS_WIN = 6 * MiB;
constexpr size_t WS_WQ = 46 * MiB;
constexpr size_t WS_WK = 50 * MiB;
constexpr size_t WS_WV = 53 * MiB;
constexpr size_t WS_WPW = 54 * MiB;
constexpr size_t WS_WOUT = 58 * MiB;
constexpr size_t WS_H = 74 * MiB;
constexpr size_t WS_Z = 138 * MiB;
constexpr size_t WS_SSQ = 292 * MiB;
constexpr size_t WS_Q = 320 * MiB, WS_K = 368 * MiB;
constexpr size_t WS_V = 416 * MiB;
constexpr size_t WS_U2 = 448 * MiB;
constexpr size_t WS_END = 480 * MiB;

__device__ __forceinline__ float fast_sigmoid(float v) { return __builtin_amdgcn_rcpf(1.0f + __builtin_amdgcn_exp2f(-1.4426950408889634f * v)); }

#define XB_TMO      128
#define XB_XCNT(j)  (256  + 64 * (j))
#define XB_XSUB(j)  (1280 + 64 * (j))
#define XB_XGEN(j)  (2304 + 64 * (j))
#define XB_TOP      3328
#define XB_TOPGEN   3392
#define XCD_BAR_WORDS 3456
#define XB_SPIN_CAP (1u << 18)

__device__ __forceinline__ unsigned xb_ld(unsigned* p)              { return __hip_atomic_load(p, __ATOMIC_RELAXED, __HIP_MEMORY_SCOPE_AGENT); }
__device__ __forceinline__ unsigned xb_add(unsigned* p, unsigned v) { return __hip_atomic_fetch_add(p, v, __ATOMIC_RELAXED, __HIP_MEMORY_SCOPE_AGENT); }
__device__ __forceinline__ unsigned xb_xcc_id() { return (unsigned)__builtin_amdgcn_s_getreg((3 << 11) | 20) & 0xFu; }
#define XB_SPIN(cond, bar) do { unsigned _sp = 0; while (cond) { __builtin_amdgcn_s_sleep(1); \
    if ((++_sp & 255u) == 0u) { if (xb_ld(&(bar)[XB_TMO])) break; if (_sp > XB_SPIN_CAP) { atomicAdd(&(bar)[XB_TMO], 1u); break; } } } } while (0)

struct XcdBarrier {
    unsigned* bar; unsigned x;
    volatile LAS unsigned* st;
};

__device__ __forceinline__ XcdBarrier xcd_barrier_post(unsigned* bar, volatile LAS unsigned* st) {
    XcdBarrier b; b.bar = bar; b.x = xb_xcc_id(); b.st = st;
    if (threadIdx.x == 0) (void)xb_add(&bar[XB_XCNT(b.x)], 1u);
    return b;
}
__device__ __forceinline__ void xcd_barrier_complete(unsigned* bar, unsigned x, unsigned& nloc, unsigned& nx) {
    const unsigned G = gridDim.x * gridDim.y * gridDim.z;
    unsigned sum, cnt, mine, sp = 0u;
    for (;;) {
        sum = 0u; cnt = 0u; mine = 0u;
#pragma unroll
        for (unsigned j = 0; j < 16; ++j) { const unsigned c = xb_ld(&bar[XB_XCNT(j)]); sum += c; cnt += (c > 0u) ? 1u : 0u; mine = (j == x) ? c : mine; }
        if (sum == G) break;
        __builtin_amdgcn_s_sleep(1);
        if ((++sp & 255u) == 0u) { if (xb_ld(&bar[XB_TMO])) break; if (sp > XB_SPIN_CAP) { atomicAdd(&bar[XB_TMO], 1u); break; } }
    }
    nloc = mine > 0u ? mine : 1u; nx = cnt > 0u ? cnt : 1u;
}

__device__ __forceinline__ void xcd_barrier(const XcdBarrier& b) {
    asm volatile("s_waitcnt vmcnt(0)" ::: "memory");
    __syncthreads();
    if (threadIdx.x == 0) {
        unsigned* bar = b.bar;
        __builtin_amdgcn_s_waitcnt(0);
        unsigned nloc = b.st[0], nx = b.st[1];
        if (nloc == 0u) { xcd_barrier_complete(bar, b.x, nloc, nx); b.st[0] = nloc; b.st[1] = nx; }
        const unsigned old = xb_add(&bar[XB_XSUB(b.x)], 1u);
        const unsigned gen = old / nloc;
        if (old + 1u == (gen + 1u) * nloc) {
            __builtin_amdgcn_fence(__ATOMIC_RELEASE, "agent");
            asm volatile("s_waitcnt vmcnt(0)" ::: "memory");
            const unsigned og = xb_add(&bar[XB_TOP], 1u);
            const unsigned tg = og / nx;
            if (og + 1u == (tg + 1u) * nx) xb_add(&bar[XB_TOPGEN], 1u);
            else XB_SPIN(xb_ld(&bar[XB_TOPGEN]) == tg, bar);
            __builtin_amdgcn_fence(__ATOMIC_ACQUIRE, "agent");
            xb_add(&bar[XB_XGEN(b.x)], 1u);
            asm volatile("s_waitcnt vmcnt(0)" ::: "memory");
        } else {
            XB_SPIN(xb_ld(&bar[XB_XGEN(b.x)]) == gen, bar);
            __builtin_amdgcn_fence(__ATOMIC_ACQUIRE, "agent");
            asm volatile("s_waitcnt vmcnt(0)" ::: "memory");
        }
    }
    __syncthreads();
}

__device__ __forceinline__ int hmap(int c) {
    if (c < 128) return c;
    if (c >= 192) return -1;
    const int q = c - 128, wc = q >> 5, fq = (q >> 3) & 3, n = (q >> 2) & 1, j = q & 3;
    return 128 + 32 * n + 16 * wc + 4 * fq + j;
}
__device__ __forceinline__ void cvt_load(float (&v)[32], const float* __restrict__ W, const float* __restrict__ gk, int Nsrc, int Ksrc, int col, int idk, int k0, int lane) {
#pragma unroll
    for (int i = 0; i < 32; ++i) { const int k = k0 + 2 * i + (lane >> 5); float x = 0.f;
        if (col >= 0 && k < Ksrc) { x = __builtin_nontemporal_load(W + (size_t)k * Nsrc + col); if (gk) x *= gk[k]; }
        if (k == idk) x = 1.f;
        v[i] = x; }
}
__device__ __forceinline__ void cvt_store(const float (&v)[32], bf16_t* __restrict__ WT, int Kout, int n0, int k0, LAS float* scr, int lane) {
#pragma unroll
    for (int i = 0; i < 32; ++i) scr[(2 * i + (lane >> 5)) * 33 + (lane & 31)] = v[i];
    asm volatile("s_waitcnt lgkmcnt(0)" ::: "memory");
    const int c = lane & 7;
#pragma unroll
    for (int j = 0; j < 4; ++j) { const int n = (lane >> 3) + 8 * j; const LAS float* s = scr + (8 * c) * 33 + n;
        u32x4 o; o.x = cvt_pk_bf16(s[0 * 33], s[1 * 33]); o.y = cvt_pk_bf16(s[2 * 33], s[3 * 33]); o.z = cvt_pk_bf16(s[4 * 33], s[5 * 33]); o.w = cvt_pk_bf16(s[6 * 33], s[7 * 33]);
        *(u32x4*)(WT + (size_t)(n0 + n) * Kout + k0 + 8 * c) = o; }
    asm volatile("s_waitcnt lgkmcnt(0)" ::: "memory");
}
struct CvtDst { bf16_t* WT; int Kout, n0, k0; };

template <int SI> __device__ __forceinline__ void conv_step(f32x2 (&av)[32], const f32x2 (&wv)[CK], const f32x2 u) {
#pragma unroll
    for (int tt = 0; tt < 32; ++tt) { const int j = SI - tt; if (j >= 0 && j <= 30) av[tt] = wv[j] * u + av[tt]; }
}

struct Args { const float* in[21]; float* out; unsigned char* ws; int ph_lo, ph_hi; };

__global__ void __launch_bounds__(NTHREADS, 2) mk_fwd(Args a) {
    extern __shared__ __attribute__((aligned(16))) unsigned char lds_raw[];
    LAS unsigned char* lds = (LAS unsigned char*)lds_raw;
    cg::grid_group grid = cg::this_grid();
    const int lo = a.ph_lo, hi = a.ph_hi;
    volatile LAS unsigned* bst = (volatile LAS unsigned*)(lds + BST_OFF);
    if (threadIdx.x < 2) bst[threadIdx.x] = 0u;
    __syncthreads();
    XcdBarrier xbar; xbar.bar = (unsigned*)a.ws; xbar.x = 0; xbar.st = bst;
    if (hi - lo > 1) xbar = xcd_barrier_post((unsigned*)a.ws, bst);
#define PHASE_BEGIN() \
    const CAS Args* ap = (const CAS Args*)__builtin_amdgcn_kernarg_segment_ptr(); asm volatile("" : "+s"(ap)); \
    int tid = threadIdx.x; asm volatile("" : "+v"(tid)); \
    const int lane = tid & 63, wave = __builtin_amdgcn_readfirstlane(tid >> 6); \
    int G = gridDim.x, bx = blockIdx.x; asm volatile("" : "+s"(G), "+s"(bx)); \
    const int gw = bx * NWAVES + wave, NGW = G * NWAVES; \
    unsigned char* ws = ap->ws; (void)lane; (void)gw; (void)NGW; (void)ws;
#define INP(i) (ap->in[i])
#define IN(k) (lo <= (k) && (k) < hi)
#ifndef USE_CG_SYNC
#define USE_CG_SYNC 0
#endif
#define SEAM(k) do { if (IN(k) && IN((k) + 1)) { if (USE_CG_SYNC || (k) == 0) grid.sync(); else xcd_barrier(xbar); } } while (0)

    for (int rep_ = 0; rep_ < REP_P0; ++rep_) if (EN_P0 && IN(0)) {
        PHASE_BEGIN();
        const float* c_in = INP(1); const int* positions = (const int*)INP(2); const float* ada_w = INP(3); const float* ada_b = INP(4); const float* w_in = INP(6);
        const float* w_q_up = INP(8); const float* w_kv_up = INP(10); const float* q_lat_g = INP(7); const float* kv_lat_g = INP(9); const float* glu_b = INP(13); const float* w_pw = INP(18); const float* w_out = INP(20);
        float* modb = (float*)(ws + WS_MOD); float* biasb = (float*)(ws + WS_BIAS); float* cosb = (float*)(ws + WS_COS); float* sinb = (float*)(ws + WS_SIN);
        bf16_t* Win_t = (bf16_t*)(ws + WS_WIN); bf16_t* Wq_t = (bf16_t*)(ws + WS_WQ); bf16_t* Wk_t = (bf16_t*)(ws + WS_WK); bf16_t* Wv_t = (bf16_t*)(ws + WS_WV);
        bf16_t* Wpw_t = (bf16_t*)(ws + WS_WPW); bf16_t* Wout_t = (bf16_t*)(ws + WS_WOUT);
        LAS float* scl = (LAS float*)lds;
        LAS float* red = (LAS float*)(lds + 32768);
        { for (int i = tid; i < NB * DM; i += NTHREADS) { const int b = i / DM, k = i % DM; scl[k * 4 + b] = fast_silu(c_in[i]); } __syncthreads(); }
        for (int rg_ = 0; rg_ < REP_GEMV; ++rg_) for (int task = bx; task < 256; task += G) {
            const int l = task >> 7, col = (task & 127) * 48 + (lane < 48 ? lane : 47);
            const float* wp = ada_w + (size_t)l * DM * 6144 + (size_t)(wave * 256) * 6144 + col;
            float a0 = 0.f, a1 = 0.f, a2 = 0.f, a3 = 0.f;
#pragma unroll 64
            for (int k = 0; k < 256; ++k) { const float wv = __builtin_nontemporal_load(wp + (size_t)k * 6144); const f32x4 s = *(const LAS f32x4*)(scl + (wave * 256 + k) * 4);
                a0 += s[0] * wv; a1 += s[1] * wv; a2 += s[2] * wv; a3 += s[3] * wv; }
            red[(wave * 4 + 0) * 64 + lane] = a0; red[(wave * 4 + 1) * 64 + lane] = a1; red[(wave * 4 + 2) * 64 + lane] = a2; red[(wave * 4 + 3) * 64 + lane] = a3;
            __syncthreads();
            if (tid < 256) { const int b = tid >> 6; float s = 0.f;
#pragma unroll
                for (int w = 0; w < 8; ++w) s += red[(w * 4 + b) * 64 + lane];
                if (lane < 48) modb[(size_t)(l * NB + b) * 6144 + col] = s + ada_b[l * 6144 + col]; }
            __syncthreads();
        }
        for (int i = bx * NTHREADS + tid; i < T * 32; i += G * NTHREADS) { const int t = i >> 5, j = i & 31;
            const float inv = 1.0f / powf(10000.0f, (float)(2 * j) * (1.0f / 64.0f)); const float ang = (float)positions[t] * inv;
            cosb[i] = cosf(ang); sinb[i] = sinf(ang); }
        for (int i = bx * NTHREADS + tid; i < DEPTH * INCP; i += G * NTHREADS) { const int l = i / INCP, c = i % INCP;
            biasb[i] = (c >= Z_CV && c < Z_CG) ? glu_b[l * 2048 + (c - Z_CV)] : 0.f; }
        {
            LAS float* scr = (LAS float*)(lds + 40960 + wave * 8448);
            constexpr int I0 = 5120, I1 = I0 + 512, I2 = I1 + 384, I3 = I2 + 128, I4 = I3 + 512, I5 = I4 + 2048;
            float va[32], vb[32]; CvtDst da, db;
#define CVT_ISSUE(IT, V, D) { const int it = (IT); \
                const int l = it / I5; int r = it % I5; \
                const float* W; int Nsrc, Ksrc, Kout, nN; bf16_t* WT; int mat; \
                if (r < I0) { mat = 0; W = w_in + (size_t)l * DM * INC; Nsrc = INC; Ksrc = DM; Kout = DM; nN = INCP / 32; WT = Win_t + (size_t)l * INCP * DM; } \
                else if (r < I1) { r -= I0; mat = 1; W = w_q_up + (size_t)l * QL * 1536; Nsrc = 1536; Ksrc = QL; Kout = KQ; nN = 64; WT = Wq_t + (size_t)l * 2048 * KQ; } \
                else if (r < I2) { r -= I1; mat = 2; W = w_kv_up + (size_t)l * KVL * 2048; Nsrc = 2048; Ksrc = KVL; Kout = KK; nN = 64; WT = Wk_t + (size_t)l * 2048 * KK; } \
                else if (r < I3) { r -= I2; mat = 3; W = w_kv_up + (size_t)l * KVL * 2048; Nsrc = 2048; Ksrc = KVL; Kout = KV; nN = 32; WT = Wv_t + (size_t)l * 1024 * KV; } \
                else if (r < I4) { r -= I3; mat = 4; W = w_pw + (size_t)l * DC * DC; Nsrc = DC; Ksrc = DC; Kout = DC; nN = 32; WT = Wpw_t + (size_t)l * DC * DC; } \
                else { r -= I4; mat = 5; W = w_out + (size_t)l * DM * DM; Nsrc = DM; Ksrc = DM; Kout = DM; nN = 64; WT = Wout_t + (size_t)l * DM * DM; } \
                const int kb = r / nN, nb = r % nN, n0 = nb * 32, k0 = kb * 64, n = n0 + (lane & 31); \
                int col = n, idk = -1; \
                if (mat == 0) col = n < INC ? n : -1; \
                else if (mat == 1) { const int hc = hmap(n & 255); col = hc >= 0 ? (n >> 8) * QKD + hc : -1; } \
                else if (mat == 2) { const int hc = hmap(n & 255); if (hc < 0) col = -1; else if (hc < 128) col = (n >> 8) * 256 + hc; else { col = -1; idk = 256 + (hc - 128); } } \
                else if (mat == 3) col = (n >> 7) * 256 + 128 + (n & 127); \
                const float* gk = (mat == 1) ? q_lat_g + l * QL : (mat == 2 || mat == 3) ? kv_lat_g + l * KVL : nullptr; \
                D.WT = WT; D.Kout = Kout; D.n0 = n0; D.k0 = k0; cvt_load(V, W, gk, Nsrc, Ksrc, col, idk, k0, lane); }
            for (int rv_ = 0; rv_ < REP_CVT; ++rv_) {
                int it0 = gw;
                if (it0 < DEPTH * I5) CVT_ISSUE(it0, va, da)
                for (; it0 < DEPTH * I5; it0 += 2 * NGW) {
                    const bool hb = it0 + NGW < DEPTH * I5, ha = it0 + 2 * NGW < DEPTH * I5;
                    if (hb) CVT_ISSUE(it0 + NGW, vb, db)
                    cvt_store(va, da.WT, da.Kout, da.n0, da.k0, scr, lane);
                    if (ha) CVT_ISSUE(it0 + 2 * NGW, va, da)
                    if (hb) cvt_store(vb, db.WT, db.Kout, db.n0, db.k0, scr, lane);
                }
            }
#undef CVT_ISSUE
        }
    }
    SEAM(0);

#pragma unroll 1
    for (int l = 0; l < DEPTH; ++l) {
        const int pb = 1 + PH_PER_LAYER * l;
        for (int rep_ = 0; rep_ < REP_A; ++rep_) if (EN_A && IN(pb)) {
            PHASE_BEGIN();
            const float* xin = (l == 0) ? INP(0) : (const float*)ap->out; const float* mod_l = (const float*)(ws + WS_MOD) + (size_t)l * NB * 6144;
            bf16_t* Hb = (bf16_t*)(ws + WS_H);
            const float* g = INP(5) + l * DM;
            for (int row0 = gw * 8; row0 < T; row0 += NGW * 8) {
                const int b = row0 / SEQ;
                f32x4 gs[8], sh[8];
#pragma unroll
                for (int j = 0; j < 8; ++j) { const int col = 4 * lane + 256 * j; const f32x4 g4 = *(const f32x4*)(g + col), s4 = *(const f32x4*)(mod_l + b * 6144 + 2048 + col);
                    gs[j] = g4 * (1.0f + s4); sh[j] = *(const f32x4*)(mod_l + b * 6144 + col); }
#pragma unroll 2
                for (int r = 0; r < 8; ++r) { const float* xr = xin + (size_t)(row0 + r) * DM + 4 * lane; f32x4 v[8]; float ss = 0.f;
#pragma unroll
                    for (int j = 0; j < 8; ++j) { v[j] = __builtin_nontemporal_load((const f32x4*)(xr + 256 * j)); ss +=     (v[j][0] * v[j][0] + v[j][1] * v[j][1]) + (v[j][2] * v[j][2] + v[j][3] * v[j][3]); }
                    const float rinv = __builtin_amdgcn_rsqf(wave_sum(ss) * (1.0f / DM) + EPS);
                    bf16_t* hr = Hb + (size_t)(row0 + r) * DM + 4 * lane;
#pragma unroll
                    for (int j = 0; j < 8; ++j) { const f32x4 o = v[j] * rinv * gs[j] + sh[j]; u32x2 w; w.x = cvt_pk_bf16(o[0], o[1]); w.y = cvt_pk_bf16(o[2], o[3]); *(u32x2*)(hr + 256 * j) = w; } }
            }
        }
        SEAM(pb);
        for (int rep_ = 0; rep_ < REP_B; ++rep_) if (EN_B && IN(pb + 1)) {
            PHASE_BEGIN();
            bf16_t* Hb = (bf16_t*)(ws + WS_H); bf16_t* Zb = (bf16_t*)(ws + WS_Z); bf16_t* Win_t = (bf16_t*)(ws + WS_WIN); float* biasb = (float*)(ws + WS_BIAS);
            pg8::Gemm g{Hb, Win_t + (size_t)l * INCP * DM, T, INCP, DM, DM, DM}; pg8::StaticOrder S; { int bxo = bx; asm volatile("" : "+s"(bxo)); S.init(T, INCP, G, bxo, WGM_B); }
            pg8::EpiZ E{Zb, INC, biasb + l * INCP, INC, (float*)(ws + WS_SSQ)};
            pg8::gemm_phase<pg8::EpiZ, pg8::StaticOrder, true, true>(lds, g, S, E);
        }
        SEAM(pb + 1);
        for (int rep_ = 0; rep_ < REP_C2; ++rep_) if (EN_C2 && IN(pb + 2)) {
            PHASE_BEGIN();
            bf16_t* Zb = (bf16_t*)(ws + WS_Z); bf16_t* U2 = (bf16_t*)(ws + WS_U2); const float* ssq = (const float*)(ws + WS_SSQ);
            const float* dw_w = INP(14); const float* dw_b = INP(15); const float* conv_ln_g = INP(16); const float* conv_ln_b = INP(17);
            bf16_t* Qb = (bf16_t*)(ws + WS_Q); bf16_t* Kb = (bf16_t*)(ws + WS_K); bf16_t* Vb = (bf16_t*)(ws + WS_V);
            bf16_t* Wq_t = (bf16_t*)(ws + WS_WQ); bf16_t* Wk_t = (bf16_t*)(ws + WS_WK); bf16_t* Wv_t = (bf16_t*)(ws + WS_WV); float* cosb = (float*)(ws + WS_COS); float* sinb = (float*)(ws + WS_SIN);
            const float* q_norm_g = INP(11); const float* k_norm_g = INP(12);
            LAS float* P = (LAS float*)(lds + EXCH_OFF);
            { pg8::Gemm g{Zb, Wq_t + (size_t)l * 2048 * KQ, T, 2048, KQ, INC, KQ}; pg8::StaticOrder S; { int bxo = bx; asm volatile("" : "+s"(bxo)); S.init(T, 2048, G, bxo, WGM_QK); }
              pg8::EpiHead E{Qb, q_norm_g + l * QKD, cosb, sinb, P, ssq, 1};
              pg8::gemm_phase<pg8::EpiHead, pg8::StaticOrder, true, true>(lds, g, S, E); }
            { pg8::Gemm g{Zb + Z_KVL, Wk_t + (size_t)l * 2048 * KK, T, 2048, KK, INC, KK};     pg8::StaticOrder S; { int bxo = bx; asm volatile("" : "+s"(bxo)); S.init(T, 2048, G, bxo, WGM_QK); }
              pg8::EpiHead E{Kb, k_norm_g + l * QKD, cosb, sinb, P, ssq, 0};
              pg8::gemm_phase<pg8::EpiHead, pg8::StaticOrder, true, true>(lds, g, S, E); }
            { pg8::Gemm g{Zb + Z_KVL, Wv_t + (size_t)l * 1024 * KV, T, 1024, KV, INC, KV}; pg8::StaticOrder S; { int bxo = bx; asm volatile("" : "+s"(bxo)); S.init(T, 1024, G, bxo, WGM_V); }
              pg8::EpiV E{Vb, ssq};
              pg8::gemm_phase<pg8::EpiV, pg8::StaticOrder, true, true>(lds, g, S, E); }
            {
                LAS bf16_t* ubuf = (LAS bf16_t*)lds;
                LAS float* red = (LAS float*)(lds + 126976);
                const int c0 = 2 * tid;
                const float* dww = dw_w + (size_t)l * CK * DC;
                const int vcu_c = (G % 8 == 0) ? (bx % 8) * (G / 8) + bx / 8 : bx, ipb_c = (T / 32 + G - 1) / G;
                for (int rc_ = 0; rc_ < REP_CONV; ++rc_) for (int item = vcu_c * ipb_c; item < T / 32 && item < (vcu_c + 1) * ipb_c; ++item) {
                    const int t0 = item * 32, s0 = t0 % SEQ;
#pragma unroll 8
                    for (int itc = 0; itc < 16; ++itc) { const int ck = tid + NTHREADS * itc; if (ck < 62 * 128) { const int si = ck >> 7, c8 = (ck & 127) * 8; u32x4 o = {0u, 0u, 0u, 0u};
                        if (s0 - 30 + si >= 0) { const bf16_t* zr = Zb + (size_t)(t0 - 30 + si) * INC; const u32x4 vv = *(const u32x4*)(zr + Z_CV + c8), gg = *(const u32x4*)(zr + Z_CGL + c8);
                            o.x = cvt_pk_bf16(bf_lo(vv.x) * fast_sigmoid(bf_lo(gg.x)), bf_hi(vv.x) * fast_sigmoid(bf_hi(gg.x))); o.y = cvt_pk_bf16(bf_lo(vv.y) * fast_sigmoid(bf_lo(gg.y)), bf_hi(vv.y) * fast_sigmoid(bf_hi(gg.y)));
                            o.z = cvt_pk_bf16(bf_lo(vv.z) * fast_sigmoid(bf_lo(gg.z)), bf_hi(vv.z) * fast_sigmoid(bf_hi(gg.z))); o.w = cvt_pk_bf16(bf_lo(vv.w) * fast_sigmoid(bf_lo(gg.w)), bf_hi(vv.w) * fast_sigmoid(bf_hi(gg.w))); }
                        *(LAS u32x4*)(ubuf + si * DC + c8) = o; } }
                    __syncthreads();
                    f32x2 wv[CK];
#pragma unroll
                    for (int j = 0; j < CK; ++j) wv[j] = *(const f32x2*)(dww + j * DC + c0);
                    f32x2 av[32];
                    { const f32x2 bb = *(const f32x2*)(dw_b + l * DC + c0);
#pragma unroll
                      for (int tt = 0; tt < 32; ++tt) av[tt] = bb; }
#define CS(SI) { const unsigned uu = *(const LAS unsigned*)(ubuf + (SI) * DC + c0); conv_step<SI>(av, wv, (f32x2){bf_lo(uu), bf_hi(uu)}); }
                    CS(0) CS(1) CS(2) CS(3) CS(4) CS(5) CS(6) CS(7) CS(8) CS(9) CS(10) CS(11) CS(12) CS(13) CS(14) CS(15) CS(16) CS(17) CS(18) CS(19) CS(20) CS(21) CS(22) CS(23) CS(24) CS(25) CS(26) CS(27) CS(28) CS(29) CS(30) CS(31) CS(32) CS(33) CS(34) CS(35) CS(36) CS(37) CS(38) CS(39) CS(40) CS(41) CS(42) CS(43) CS(44) CS(45) CS(46) CS(47) CS(48) CS(49) CS(50) CS(51) CS(52) CS(53) CS(54) CS(55) CS(56) CS(57) CS(58) CS(59) CS(60) CS(61)
#undef CS
                    float v[64];
#pragma unroll
                    for (int tt = 0; tt < 32; ++tt) { v[tt] = av[tt][0] + av[tt][1]; v[32 + tt] = av[tt][0] * av[tt][0] + av[tt][1] * av[tt][1]; }
                    { const bool up = (lane & 32) != 0;
#pragma unroll
                      for (int i = 0; i < 32; ++i) { const float send = up ? v[i] : v[i + 32]; const float keep = up ? v[i + 32] : v[i]; v[i] = keep + xswap32(send, up); } }
#define TRED(STEP) { const bool up = (lane & STEP) != 0; _Pragma("unroll") for (int i = 0; i < STEP; ++i) { const float send = up ? v[i] : v[i + STEP]; const float keep = up ? v[i + STEP] : v[i]; v[i] = keep + xshfl<STEP>(send); } }
                    TRED(16) TRED(8) TRED(4) TRED(2) TRED(1)
#undef TRED
                    red[wave * 64 + lane] = v[0];
                    __syncthreads();
                    float tot = 0.f;
#pragma unroll
                    for (int w = 0; w < 8; ++w) tot += red[w * 64 + lane];
                    const float other = xswap32(tot, lane >= 32);
                    const float s1 = lane < 32 ? tot : other, s2 = lane < 32 ? other : tot;
                    const float mean = s1 * (1.0f / DC), var = s2 * (1.0f / DC) - mean * mean, rstd = __builtin_amdgcn_rsqf(var + EPS);
                    const f32x2 lg = *(const f32x2*)(conv_ln_g + l * DC + c0), lb = *(const f32x2*)(conv_ln_b + l * DC + c0);
#pragma unroll
                    for (int tt = 0; tt < 32; ++tt) { const float m = __int_as_float(__builtin_amdgcn_readlane(__float_as_int(mean), tt)), rs = __int_as_float(__builtin_amdgcn_readlane(__float_as_int(rstd), tt));
                        const float o0 = (av[tt][0] - m) * rs * lg[0] + lb[0], o1 = (av[tt][1] - m) * rs * lg[1] + lb[1];
                        *(unsigned*)(U2 + (size_t)(t0 + tt) * DC + c0) = cvt_pk_bf16(fast_silu(o0), fast_silu(o1)); }
                    __syncthreads();
                }
            }
        }
        SEAM(pb + 2);
        if (EN_D && IN(pb + 3)) {
            PHASE_BEGIN();
            bf16_t* Hb = (bf16_t*)(ws + WS_H); bf16_t* Zb = (bf16_t*)(ws + WS_Z); bf16_t* Qb = (bf16_t*)(ws + WS_Q); bf16_t* Kb = (bf16_t*)(ws + WS_K); bf16_t* Vb = (bf16_t*)(ws + WS_V);
            bf16_t* U2 = (bf16_t*)(ws + WS_U2); bf16_t* Wpw_t = (bf16_t*)(ws + WS_WPW); const float* b_pw = INP(19);
            const int vcu = (G % 8 == 0) ? (bx % 8) * (G / 8) + bx / 8 : bx;
            for (int rep_ = 0; rep_ < REP_ATT; ++rep_) for (int it = vcu; it < NB * NH * 8; it += G) {
                const int bh = it >> 3, xq = it & 7, b = bh / NH, h = bh % NH;
                const bf16_t* Qh = Qb + (size_t)bh * SEQ * QKD; const bf16_t* Kh = Kb + (size_t)bh * SEQ * QKD; const bf16_t* Vh = Vb + (size_t)bh * SEQ * VD;
                bf16_t* mixp = Hb + (size_t)b * SEQ * DM + h * VD; const bf16_t* zg = Zb + (size_t)b * SEQ * INC + Z_MG + h * VD;
#pragma unroll 1
                for (int pass = 0; pass < 2 * EN_ATT; ++pass) att::attn_block(Qh, Kh, Vh, pass ? xq : 15 - xq, mixp, zg, (LAS char*)lds);
            }
            for (int rep_ = 0; rep_ < REP_PW; ++rep_) if (EN_PW) { pg8::Gemm g{U2, Wpw_t + (size_t)l * DC * DC, T, DC, DC, DC, DC}; pg8::StaticOrder S; { int bxo = bx; asm volatile("" : "+s"(bxo)); S.init(T, DC, G, bxo, WGM_PW); }
              pg8::EpiPw E{Hb, Zb, b_pw + l * DC};
              pg8::gemm_phase<pg8::EpiPw, pg8::StaticOrder, true, true>(lds, g, S, E); }
        }
        SEAM(pb + 3);
        for (int rep_ = 0; rep_ < (l == 0 ? REP_E0 : 1); ++rep_) if (EN_E && IN(pb + 4)) {
            PHASE_BEGIN();
            bf16_t* Hb = (bf16_t*)(ws + WS_H); bf16_t* Wout_t = (bf16_t*)(ws + WS_WOUT);
            const float* xin = (l == 0) ? INP(0) : (const float*)ap->out; const float* mod_l = (const float*)(ws + WS_MOD) + (size_t)l * NB * 6144;
            pg8::Gemm g{Hb, Wout_t + (size_t)l * DM * DM, T, DM, DM, DM, DM}; pg8::StaticOrder S; { int bxo = bx; asm volatile("" : "+s"(bxo)); S.init(T, DM, G, bxo, WGM_E); }
            pg8::EpiOut E{xin, ap->out, mod_l + 4096};
            pg8::gemm_phase<pg8::EpiOut, pg8::StaticOrder, true, true>(lds, g, S, E);
        }
        SEAM(pb + 4);
    }
#undef IN
#undef SEAM
}

extern "C" void kernel_launch(void* const* d_in, const int* in_sizes, int n_in, void* d_out, int out_size, void* d_ws, size_t ws_size, hipStream_t stream) {
    static int grid = 0;
    if (grid == 0) {
        if (n_in != 21 || in_sizes[0] != T * DM || out_size != T * DM || ws_size < WS_END) { fprintf(stderr, "kernel_launch: unexpected shapes (n_in %d, in0 %d, out %d, ws %zu)\n", n_in, n_in > 0 ? in_sizes[0] : -1, out_size, ws_size); grid = -1; return; }
        int dev = 0, cus = 0, per_cu = 0;
        (void)hipGetDevice(&dev); (void)hipDeviceGetAttribute(&cus, hipDeviceAttributeMultiprocessorCount, dev);
        if (hipFuncSetAttribute((const void*)mk_fwd, hipFuncAttributeMaxDynamicSharedMemorySize, LDS_BYTES) != hipSuccess) { fprintf(stderr, "kernel_launch: hipFuncSetAttribute failed\n"); grid = -1; return; }
        if (hipOccupancyMaxActiveBlocksPerMultiprocessor(&per_cu, (const void*)mk_fwd, NTHREADS, LDS_BYTES) != hipSuccess || per_cu < 1) { fprintf(stderr, "kernel_launch: occupancy query says %d blocks per CU\n", per_cu); per_cu = 1; }
        (void)hipGetLastError();
        grid = cus * 1;
        fprintf(stderr, "kernel_launch: %d CUs, occupancy %d, grid %d\n", cus, per_cu, grid);
    }
    if (grid < 0) return;
    Args a{};
    for (int i = 0; i < 21; ++i) a.in[i] = (const float*)d_in[i];
    a.out = (float*)d_out; a.ws = (unsigned char*)d_ws;
#if MK_ONE_LAUNCH
    (void)hipMemsetAsync(d_ws, 0, 16384, stream);
    a.ph_lo = 0; a.ph_hi = N_PHASES;
    void* args[] = {&a};
    hipError_t e = hipLaunchCooperativeKernel((const void*)mk_fwd, dim3(grid), dim3(NTHREADS), args, LDS_BYTES, stream);
    if (e != hipSuccess) fprintf(stderr, "kernel_launch: cooperative launch failed: %s (grid %d)\n", hipGetErrorString(e), grid);
#else
    for (int p = 0; p < N_PHASES; ++p) { a.ph_lo = p; a.ph_hi = p + 1; hipLaunchKernelGGL(mk_fwd, dim3(grid), dim3(NTHREADS), LDS_BYTES, stream, a); }
#endif
}
```

```cpp
#include <hip/hip_runtime.h>
#include <hip/hip_cooperative_groups.h>
#include <cstdio>
#include <cstdint>
namespace cg = cooperative_groups;

constexpr int DM = 2048, NB = 4, SEQ = 4096, T = NB * SEQ, DEPTH = 2;
constexpr int NH = 8, QKD = 192, VD = 128, QL = 512, KVL = 256, DC = 1024, CK = 31;
constexpr int INC = 4928, INCP = 5120;
constexpr int Z_KVL = 512, Z_KR = 768, Z_MG = 832, Z_CV = 1856, Z_CGL = 2880, Z_CG = 3904;
constexpr int KQ = 512, KK = 384, KV = 256;
constexpr float EPS = 1e-6f;

template <int K> __device__ __forceinline__ float xshfl(float v) { static_assert(K >= 1 && K < 32, "xshfl"); return __int_as_float(__builtin_amdgcn_ds_swizzle(__float_as_int(v), (K << 10) | 0x1f)); }
__device__ __forceinline__ float xsum32(float v) { auto rr = __builtin_amdgcn_permlane32_swap(__float_as_uint(v), __float_as_uint(v), false, false); return __uint_as_float(rr[0]) + __uint_as_float(rr[1]); }
__device__ __forceinline__ float xswap32(float v, bool upper) { auto rr = __builtin_amdgcn_permlane32_swap(__float_as_uint(v), __float_as_uint(v), false, false); return __uint_as_float(upper ? rr[0] : rr[1]); }
__device__ __forceinline__ float wave_sum(float v) { v += xshfl<1>(v); v += xshfl<2>(v); v += xshfl<4>(v); v += xshfl<8>(v); v += xshfl<16>(v); return xsum32(v); }
namespace pg8 {
#define PG8_LAS __attribute__((address_space(3)))
typedef unsigned short bf16_t;
typedef short bf16x8 __attribute__((ext_vector_type(8)));
typedef float f32x4 __attribute__((ext_vector_type(4)));
typedef unsigned u32x4 __attribute__((ext_vector_type(4)));
constexpr int BM = 256, BK = 64, HALF = 128, HTB = HALF * BK * 2  , STAGE_BYTES = 8 * HTB, NXCD = 8, WGM = 4;

__host__ __device__ __forceinline__ int lds_byte(int r, int c) { const int st = (r >> 4) * 2 + (c >> 5), rr = r & 15, cc = c & 31, ob = rr * 64 + cc * 2; return st * 1024 + (ob ^ (((ob >> 9) & 1) << 5)); }
__host__ __device__ __forceinline__ void stage_rc(int b, int& R, int& C) { const int st = b / 1024, sb = b % 1024, swz = sb ^ (((sb >> 9) & 1) << 5); R = (st >> 1) * 16 + swz / 64; C = (st & 1) * 32 + (swz % 64) / 2; }
__host__ __device__ __forceinline__ int perm32(int rho) { const int n = rho >> 4, i = rho & 15; return 8 * (i >> 2) + 4 * n + (i & 3); }

struct Unit { int pm, pn; };
struct Gemm { const bf16_t* A; const bf16_t* Bt; int M, N, K, lda, ldb; };

struct StaticOrder {
    int nM, nN, nwg, G, c, wgm;
    __host__ __device__ void init(int M, int N, int G_, int c_, int wgm_ = WGM) { nM = M / BM; nN = N / BM; nwg = nM * nN; G = G_; c = c_; wgm = wgm_; }
    __host__ __device__ bool next(int i, Unit& u) const {
        const int L = i * G + c; if (L >= nwg) return false;
        int wgid = L; { const int q = nwg / NXCD, r = nwg % NXCD, xcd = wgid % NXCD, off = wgid / NXCD; wgid = (xcd < r ? xcd * (q + 1) : r * (q + 1) + (xcd - r) * q) + off; }
        const int nig = wgm * nN, gid = wgid / nig, fm = gid * wgm, gsz = (nM - fm) < wgm ? (nM - fm) : wgm;
        u.pm = fm + ((wgid % nig) % gsz); u.pn = (wgid % nig) / gsz; return true;
    }
    __device__ __forceinline__ void a_ready(const Unit&) const {}
    __device__ __forceinline__ void done(const Unit&) const {}
};
__device__ __forceinline__ unsigned cvt_pk_bf16(float lo, float hi) { unsigned r; asm volatile("v_cvt_pk_bf16_f32 %0, %1, %2" : "=v"(r) : "v"(lo), "v"(hi)); return r; }
typedef float f32x2 __attribute__((ext_vector_type(2)));
typedef unsigned u32x2 __attribute__((ext_vector_type(2)));
__device__ __forceinline__ float fast_silu(float v) { return v * __builtin_amdgcn_rcpf(1.0f + __builtin_amdgcn_exp2f(-1.4426950408889634f * v)); }
__device__ __forceinline__ float bf_lo(unsigned u) { return __uint_as_float(u << 16); }
__device__ __forceinline__ float bf_hi(unsigned u) { return __uint_as_float(u & 0xffff0000u); }

struct EpiZ {
    static constexpr bool PERM = true, AFTER_DRAIN = false;
    bf16_t* O; int ldc; const float* bias; int nvalid; float* ssq;
    __device__ __forceinline__ void operator()(const f32x4 (&acc)[2][2][4][2], const Unit& u, int wr, int wc, int fr, int fq) const {
        asm volatile("" : "+v"(fr), "+v"(fq), "+s"(wr), "+s"(wc));
        const int row0 = u.pm * BM + wr * 64 + fr; const int col0 = u.pn * BM + wc * 32 + 8 * fq;
        f32x4 bv[2][2];
#pragma unroll
        for (int bj = 0; bj < 2; ++bj)
#pragma unroll
            for (int n = 0; n < 2; ++n) bv[bj][n] = *(const f32x4*)(bias + col0 + bj * HALF + 4 * n);
        if (u.pn < 3) {
#pragma unroll
            for (int ai = 0; ai < 2; ++ai)
#pragma unroll
                for (int m = 0; m < 4; ++m) { float s = 0.f;
#pragma unroll
                    for (int bj = 0; bj < 2; ++bj)
#pragma unroll
                        for (int n = 0; n < 2; ++n) { const f32x4 x = acc[ai][bj][m][n] + bv[bj][n]; s += (x[0] * x[0] + x[1] * x[1]) + (x[2] * x[2] + x[3] * x[3]); }
                    s += xshfl<16>(s); s = xsum32(s);
                    if (fq == 0) ssq[(size_t)(row0 + ai * HALF + m * 16) * 12 + u.pn * 4 + wc] = s; }
        }
#pragma unroll
        for (int ai = 0; ai < 2; ++ai)
#pragma unroll
            for (int m = 0; m < 4; ++m) { bf16_t* rowp = O + (size_t)(row0 + ai * HALF + m * 16) * ldc + col0;
#pragma unroll
                for (int bj = 0; bj < 2; ++bj) { const f32x4 v0 = acc[ai][bj][m][0] + bv[bj][0], v1 = acc[ai][bj][m][1] + bv[bj][1];
                    u32x4 w; w.x = cvt_pk_bf16(v0[0], v0[1]); w.y = cvt_pk_bf16(v0[2], v0[3]); w.z = cvt_pk_bf16(v1[0], v1[1]); w.w = cvt_pk_bf16(v1[2], v1[3]);
                    if (col0 + bj * HALF < nvalid) *(u32x4*)(rowp + bj * HALF) = w; } }
    }
};
struct EpiV {
    static constexpr bool PERM = false, AFTER_DRAIN = false;
    bf16_t* O; const float* ssq;
    __device__ __forceinline__ void operator()(const f32x4 (&acc)[2][2][4][2], const Unit& u, int wr, int wc, int fr, int fq) const {
        asm volatile("" : "+v"(fr), "+v"(fq), "+s"(wr), "+s"(wc));
        const int t0 = u.pm * BM, b = t0 / SEQ, s0 = t0 % SEQ;
        float rk8[2][4];
#pragma unroll
        for (int ai = 0; ai < 2; ++ai)
#pragma unroll
            for (int m = 0; m < 4; ++m) { const f32x4 sl = *(const f32x4*)(ssq + (size_t)(t0 + ai * HALF + wr * 64 + m * 16 + fr) * 12 + 8);
                rk8[ai][m] = __builtin_amdgcn_rsqf(((sl[0] + sl[1]) + (sl[2] + sl[3])) * (1.0f / 256.0f) + 1e-6f); }
#pragma unroll
        for (int ai = 0; ai < 2; ++ai)
#pragma unroll
            for (int m = 0; m < 4; ++m) { const int r = ai * HALF + wr * 64 + m * 16 + fr;
                const float rk = rk8[ai][m];
#pragma unroll
                for (int bj = 0; bj < 2; ++bj) { bf16_t* dst = O + ((size_t)((b * NH + 2 * u.pn + bj) * SEQ + s0 + r)) * VD + wc * 32 + 4 * fq;
#pragma unroll
                    for (int n = 0; n < 2; ++n) { const f32x4 v = acc[ai][bj][m][n] * rk; u32x2 w; w.x = cvt_pk_bf16(v[0], v[1]); w.y = cvt_pk_bf16(v[2], v[3]); *(u32x2*)(dst + 16 * n) = w; } } }
    }
};
struct EpiPw {
    static constexpr bool PERM = true, AFTER_DRAIN = false;
    bf16_t* mix; const bf16_t* z; const float* bpw;
    __device__ __forceinline__ void operator()(const f32x4 (&acc)[2][2][4][2], const Unit& u, int wr, int wc, int fr, int fq) const {
        asm volatile("" : "+v"(fr), "+v"(fq), "+s"(wr), "+s"(wc));
        const int col0 = u.pn * BM + wc * 32 + 8 * fq;
        f32x4 bv[2][2];
#pragma unroll
        for (int bj = 0; bj < 2; ++bj)
#pragma unroll
            for (int n = 0; n < 2; ++n) bv[bj][n] = *(const f32x4*)(bpw + col0 + bj * HALF + 4 * n);
#pragma unroll
        for (int ai = 0; ai < 2; ++ai)
#pragma unroll
            for (int m = 0; m < 4; ++m) { const size_t t = (size_t)(u.pm * BM + ai * HALF + wr * 64 + m * 16 + fr);
#pragma unroll
                for (int bj = 0; bj < 2; ++bj) { const int c = col0 + bj * HALF; const u32x4 gz = *(const u32x4*)(z + t * INC + Z_CG + c);
                    const f32x4 v0 = acc[ai][bj][m][0] + bv[bj][0], v1 = acc[ai][bj][m][1] + bv[bj][1];
                    u32x4 w; w.x = cvt_pk_bf16(v0[0] * fast_silu(bf_lo(gz.x)), v0[1] * fast_silu(bf_hi(gz.x))); w.y = cvt_pk_bf16(v0[2] * fast_silu(bf_lo(gz.y)), v0[3] * fast_silu(bf_hi(gz.y)));
                    w.z = cvt_pk_bf16(v1[0] * fast_silu(bf_lo(gz.z)), v1[1] * fast_silu(bf_hi(gz.z))); w.w = cvt_pk_bf16(v1[2] * fast_silu(bf_lo(gz.w)), v1[3] * fast_silu(bf_hi(gz.w)));
                    *(u32x4*)(mix + t * DM + DC + c) = w; }
                if (m & 1) asm volatile("" ::: "memory"); }
    }
};
struct EpiOut {
    static constexpr bool PERM = true, AFTER_DRAIN = false;
    const float* xin; float* xout; const float* gate; int nts;
    __device__ __forceinline__ void operator()(const f32x4 (&acc)[2][2][4][2], const Unit& u, int wr, int wc, int fr, int fq) const {
        asm volatile("" : "+v"(fr), "+v"(fq), "+s"(wr), "+s"(wc));
        const int col0 = u.pn * BM + wc * 32 + 8 * fq; const int b = (u.pm * BM) / SEQ;
        f32x4 gv[2][2];
#pragma unroll
        for (int bj = 0; bj < 2; ++bj)
#pragma unroll
            for (int n = 0; n < 2; ++n) gv[bj][n] = *(const f32x4*)(gate + (size_t)b * 6144 + col0 + bj * HALF + 4 * n);
#pragma unroll
        for (int ai = 0; ai < 2; ++ai)
#pragma unroll
            for (int m = 0; m < 4; ++m) { const size_t off = (size_t)(u.pm * BM + ai * HALF + wr * 64 + m * 16 + fr) * DM + col0;
#pragma unroll
                for (int bj = 0; bj < 2; ++bj)
#pragma unroll
                    for (int n = 0; n < 2; ++n) { const f32x4 xv = *(const f32x4*)(xin + off + bj * HALF + 4 * n);
                        const f32x4 ov = xv + gv[bj][n] * acc[ai][bj][m][n];
                        if (nts) __builtin_nontemporal_store(ov, (f32x4*)(xout + off + bj * HALF + 4 * n)); else *(f32x4*)(xout + off + bj * HALF + 4 * n) = ov; }
                if (m == 3) asm volatile("" ::: "memory"); }
    }
};
struct EpiHead {
    static constexpr bool PERM = true, AFTER_DRAIN = false;
    bf16_t* O; const float* g; const float* cs; const float* sn; PG8_LAS float* P; const float* ssq; int qmode;
    __device__ __forceinline__ void operator()(const f32x4 (&acc)[2][2][4][2], const Unit& u, int wr, int wc, int fr, int fq) const {
        asm volatile("" : "+v"(fr), "+v"(fq), "+s"(wr), "+s"(wc));
        float rl8[2][4];
#pragma unroll
        for (int ai = 0; ai < 2; ++ai)
#pragma unroll
            for (int m = 0; m < 4; ++m) { const float* sp = ssq + (size_t)(u.pm * BM + ai * HALF + wr * 64 + m * 16 + fr) * 12; float lat;
                if (qmode) { const f32x4 a4 = *(const f32x4*)sp, b4 = *(const f32x4*)(sp + 4); lat = (((a4[0] + a4[1]) + (a4[2] + a4[3])) + ((b4[0] + b4[1]) + (b4[2] + b4[3]))) * (1.0f / 512.0f); }
                else { const f32x4 a4 = *(const f32x4*)(sp + 8); lat = ((a4[0] + a4[1]) + (a4[2] + a4[3])) * (1.0f / 256.0f); }
                rl8[ai][m] = __builtin_amdgcn_rsqf(lat + 1e-6f); }
#pragma unroll
        for (int ai = 0; ai < 2; ++ai)
#pragma unroll
            for (int m = 0; m < 4; ++m) { float s0 = 0.f, s1 = 0.f;
#pragma unroll
                for (int n = 0; n < 2; ++n) { const f32x4 x = acc[ai][0][m][n], y = acc[ai][1][m][n];
                    s0 += (x[0] * x[0] + x[1] * x[1]) + (x[2] * x[2] + x[3] * x[3]); s1 += (y[0] * y[0] + y[1] * y[1]) + (y[2] * y[2] + y[3] * y[3]); }
                s0 += xshfl<16>(s0); s0 = xsum32(s0); s1 += xshfl<16>(s1); s1 = xsum32(s1);
                if (fq == 0) { PG8_LAS float* pp = P + ((ai * HALF + wr * 64 + m * 16 + fr) * 4 + wc) * 2; pp[0] = s0; pp[1] = s1; } }
        asm volatile("s_waitcnt lgkmcnt(0)" ::: "memory"); __builtin_amdgcn_s_barrier(); asm volatile("" ::: "memory");
        const int t0 = u.pm * BM, b = t0 / SEQ, s0r = t0 % SEQ, h = u.pn, e = 16 * wc + 4 * fq;
        f32x4 g0[2], g1 = {0.f, 0.f, 0.f, 0.f}, g2 = {0.f, 0.f, 0.f, 0.f};
#pragma unroll
        for (int n = 0; n < 2; ++n) g0[n] = *(const f32x4*)(g + wc * 32 + 8 * fq + 4 * n);
        if (wc < 2) { g1 = *(const f32x4*)(g + 128 + e); g2 = *(const f32x4*)(g + 160 + e); }
#pragma unroll
        for (int ai = 0; ai < 2; ++ai)
#pragma unroll
            for (int m = 0; m < 4; ++m) { const int r = ai * HALF + wr * 64 + m * 16 + fr;
                const f32x4 pa = *(const PG8_LAS f32x4*)(P + r * 8), pb = *(const PG8_LAS f32x4*)(P + r * 8 + 4);
                const float S0 = (pa[0] + pa[2]) + (pb[0] + pb[2]), S1 = (pa[1] + pa[3]) + (pb[1] + pb[3]);
                const float rl = rl8[ai][m], rr = qmode ? rl : 1.0f;
                const float f = __builtin_amdgcn_rsqf((rl * rl * S0 + rr * rr * S1) * (1.0f / 192.0f) + 1e-6f), fn = rl * f, fp = rr * f;
                bf16_t* dst = O + ((size_t)((b * NH + h) * SEQ + s0r + r)) * QKD;
                { const f32x4 v0 = acc[ai][0][m][0] * fn * g0[0], v1 = acc[ai][0][m][1] * fn * g0[1]; u32x4 w; w.x = cvt_pk_bf16(v0[0], v0[1]); w.y = cvt_pk_bf16(v0[2], v0[3]); w.z = cvt_pk_bf16(v1[0], v1[1]); w.w = cvt_pk_bf16(v1[2], v1[3]); *(u32x4*)(dst + wc * 32 + 8 * fq) = w; }
                if (wc < 2) { const size_t tt = (size_t)(t0 + r) * 32 + e; const f32x4 c4 = *(const f32x4*)(cs + tt), s4 = *(const f32x4*)(sn + tt);
                    const f32x4 x1 = acc[ai][1][m][0] * fp * g1, x2 = acc[ai][1][m][1] * fp * g2; const f32x4 o1 = x1 * c4 - x2 * s4, o2 = x2 * c4 + x1 * s4;
                    u32x2 w1, w2; w1.x = cvt_pk_bf16(o1[0], o1[1]); w1.y = cvt_pk_bf16(o1[2], o1[3]); w2.x = cvt_pk_bf16(o2[0], o2[1]); w2.y = cvt_pk_bf16(o2[2], o2[3]);
                    *(u32x2*)(dst + 128 + e) = w1; *(u32x2*)(dst + 160 + e) = w2; }
                if (m & 1) asm volatile("" ::: "memory"); }
    }
};
template <class Epi, class Sched, bool ALIGN_EPI = false, bool SP2 = false>
__device__ __forceinline__ void gemm_phase(PG8_LAS unsigned char* lds, const Gemm g, const Sched& S, const Epi& E) {
    int tid_ = threadIdx.x; asm volatile("" : "+v"(tid_));
    const int tid = tid_, wid = __builtin_amdgcn_readfirstlane(tid >> 6), lane = tid & 63, wr = wid >> 2, wc = wid & 3, fr = lane & 15, fq = lane >> 4;
    const int K = g.K, nt = K / BK;
    unsigned voffA[2], voffB[2];
#pragma unroll
    for (int i = 0; i < 2; ++i) { int R, C; stage_rc(tid * 16 + i * 8192, R, C); const int Rb = Epi::PERM ? ((R & ~31) + perm32(R & 31)) : R;
        voffA[i] = (unsigned)(R * g.lda + C) * 2u; voffB[i] = (unsigned)(Rb * g.ldb + C) * 2u; }
    const size_t kstep = (size_t)(BK * 2);
    const size_t hstepA = (size_t)HALF * g.lda * 2, hstepB = (size_t)HALF * g.ldb * 2;
    const size_t tstepA = 2 * hstepA, tstepB = 2 * hstepB;
    const unsigned ldsw = (unsigned)wid * 1024u;
    const int aoff = lds_byte(wr * 64 + fr, fq * 8), boff = lds_byte(wc * 32 + fr, fq * 8);
#define PG8_SA(b, h) (((b) * 2 + (h)) * HTB)
#define PG8_SB(b, h) ((4 + (b) * 2 + (h)) * HTB)
#define PG8_STAGE(bufoff, gbase, voff) do { _Pragma("unroll") for (int _i = 0; _i < 2; ++_i) \
        __builtin_amdgcn_global_load_lds((const unsigned*)((const char*)(gbase) + (voff)[_i]), (PG8_LAS unsigned*)(lds + (bufoff) + ldsw + _i * 8192), 16, 0, 0); } while (0)
#define PG8_LDA(dst, b, h) do { _Pragma("unroll") for (int m = 0; m < 4; ++m) _Pragma("unroll") for (int k = 0; k < 2; ++k) dst[m][k] = *(const PG8_LAS bf16x8*)(lds + PG8_SA(b, h) + aoff + m * 2048 + k * 1024); } while (0)
#define PG8_LDB(dst, b, h) do { _Pragma("unroll") for (int n = 0; n < 2; ++n) _Pragma("unroll") for (int k = 0; k < 2; ++k) dst[n][k] = *(const PG8_LAS bf16x8*)(lds + PG8_SB(b, h) + boff + n * 2048 + k * 1024); } while (0)
#define PG8_MMA(ai, bj, At, Bt) do { __builtin_amdgcn_s_setprio(1); _Pragma("unroll") for (int m = 0; m < 4; ++m) _Pragma("unroll") for (int n = 0; n < 2; ++n) _Pragma("unroll") for (int k = 0; k < 2; ++k) \
        acc[ai][bj][m][n] = __builtin_amdgcn_mfma_f32_16x16x32_bf16(Bt[n][k], At[m][k], acc[ai][bj][m][n], 0, 0, 0); __builtin_amdgcn_s_setprio(0); } while (0)
#define PG8_WAIT_V(n) asm volatile("s_waitcnt vmcnt(" #n ")" ::: "memory")
#define PG8_WAIT_L(n) asm volatile("s_waitcnt lgkmcnt(" #n ")" ::: "memory")
#define PG8_BAR __builtin_amdgcn_s_barrier()
#define PG8_SCHED __builtin_amdgcn_sched_barrier(0)
    Unit cur, nxt; int ui = 0;
    if (!S.next(0, cur)) return;
    f32x4 acc[2][2][4][2];
#pragma unroll
    for (int a = 0; a < 2; ++a)
#pragma unroll
        for (int b = 0; b < 2; ++b)
#pragma unroll
            for (int m = 0; m < 4; ++m)
#pragma unroll
                for (int n = 0; n < 2; ++n) acc[a][b][m][n] = (f32x4){0.f, 0.f, 0.f, 0.f};
    bf16x8 At[4][2], B0[2][2], B1[2][2];
    const char* cA = (const char*)g.A + (size_t)cur.pm * tstepA; const char* cB = (const char*)g.Bt + (size_t)cur.pn * tstepB;
    S.a_ready(cur);
    if constexpr (SP2) {
        PG8_STAGE(PG8_SB(0, 0), cB, voffB); PG8_STAGE(PG8_SB(0, 1), cB + hstepB, voffB); PG8_STAGE(PG8_SA(0, 0), cA, voffA); PG8_STAGE(PG8_SA(0, 1), cA + hstepA, voffA);
        if (wr == 1) PG8_BAR;
        PG8_WAIT_V(2); PG8_BAR;
        PG8_STAGE(PG8_SB(1, 0), cB + kstep, voffB); PG8_STAGE(PG8_SA(1, 0), cA + kstep, voffA); PG8_STAGE(PG8_SB(1, 1), cB + hstepB + kstep, voffB);
        PG8_WAIT_V(6); PG8_BAR;
    } else {
        PG8_STAGE(PG8_SB(0, 0), cB, voffB); PG8_STAGE(PG8_SA(0, 0), cA, voffA); PG8_STAGE(PG8_SB(0, 1), cB + hstepB, voffB); PG8_STAGE(PG8_SA(0, 1), cA + hstepA, voffA);
        if (wr == 1) PG8_BAR;
        PG8_WAIT_V(4); PG8_BAR;
        PG8_STAGE(PG8_SB(1, 0), cB + kstep, voffB); PG8_STAGE(PG8_SA(1, 0), cA + kstep, voffA); PG8_STAGE(PG8_SB(1, 1), cB + hstepB + kstep, voffB);
        PG8_WAIT_V(6); PG8_BAR;
    }
    for (;;) {
        const bool has_next = S.next(ui + 1, nxt);
        const char* nA = has_next ? (const char*)g.A + (size_t)nxt.pm * tstepA : cA; const char* nB = has_next ? (const char*)g.Bt + (size_t)nxt.pn * tstepB : cB;
        for (int t = 0; t < nt; t += 2) {
            const bool last = (t == nt - 2);
            const char* a1 = cA + (size_t)(t + 1) * kstep;
            const char* a2 = last ? nA : cA + (size_t)(t + 2) * kstep; const char* b2 = last ? nB : cB + (size_t)(t + 2) * kstep;
            const char* a3 = a2 + kstep; const char* b3 = b2 + kstep;
            if (last && has_next) S.a_ready(nxt);
            if constexpr (SP2) {
            PG8_LDB(B0, 0, 0); PG8_LDB(B1, 0, 1); PG8_SCHED; PG8_LDA(At, 0, 0); PG8_STAGE(PG8_SA(1, 1), a1 + hstepA, voffA);
            PG8_WAIT_V(8); PG8_WAIT_L(0); PG8_BAR; PG8_MMA(0, 0, At, B0); PG8_MMA(0, 1, At, B1); PG8_BAR; PG8_SCHED;
            PG8_LDA(At, 0, 1); PG8_STAGE(PG8_SB(0, 0), b2, voffB); PG8_STAGE(PG8_SB(0, 1), b2 + hstepB, voffB); PG8_STAGE(PG8_SA(0, 0), a2, voffA);
            PG8_WAIT_V(8); PG8_WAIT_L(0); PG8_BAR; PG8_MMA(1, 0, At, B0); PG8_MMA(1, 1, At, B1); PG8_BAR; PG8_SCHED;
            PG8_LDB(B0, 1, 0); PG8_LDB(B1, 1, 1); PG8_SCHED; PG8_LDA(At, 1, 0); PG8_STAGE(PG8_SA(0, 1), a2 + hstepA, voffA);
            PG8_WAIT_V(8); PG8_WAIT_L(0); PG8_BAR; PG8_MMA(0, 0, At, B0); PG8_MMA(0, 1, At, B1); PG8_BAR; PG8_SCHED;
            PG8_LDA(At, 1, 1); PG8_STAGE(PG8_SB(1, 0), b3, voffB); PG8_STAGE(PG8_SB(1, 1), b3 + hstepB, voffB); PG8_STAGE(PG8_SA(1, 0), a3, voffA);
            PG8_WAIT_V(8); PG8_WAIT_L(0); PG8_BAR; PG8_MMA(1, 0, At, B0); PG8_MMA(1, 1, At, B1); PG8_BAR; PG8_SCHED;
            } else {
            PG8_LDB(B0, 0, 0); PG8_SCHED; PG8_LDA(At, 0, 0); PG8_STAGE(PG8_SA(1, 1), a1 + hstepA, voffA);
            PG8_WAIT_L(8); PG8_BAR; PG8_WAIT_L(0); PG8_MMA(0, 0, At, B0); PG8_BAR; PG8_SCHED;
            PG8_LDB(B1, 0, 1); PG8_STAGE(PG8_SB(0, 0), b2, voffB);
            PG8_BAR; PG8_WAIT_L(0); PG8_MMA(0, 1, At, B1); PG8_BAR;
            PG8_LDA(At, 0, 1); PG8_STAGE(PG8_SA(0, 0), a2, voffA);
            PG8_BAR; PG8_WAIT_L(0); PG8_MMA(1, 0, At, B0); PG8_BAR; PG8_SCHED;
            PG8_STAGE(PG8_SB(0, 1), b2 + hstepB, voffB);
            PG8_WAIT_V(6); PG8_BAR; PG8_MMA(1, 1, At, B1); PG8_BAR;
            PG8_LDB(B0, 1, 0); PG8_SCHED; PG8_LDA(At, 1, 0); PG8_STAGE(PG8_SA(0, 1), a2 + hstepA, voffA);
            PG8_WAIT_L(8); PG8_BAR; PG8_WAIT_L(0); PG8_MMA(0, 0, At, B0); PG8_BAR; PG8_SCHED;
            PG8_LDB(B1, 1, 1); PG8_STAGE(PG8_SB(1, 0), b3, voffB);
            PG8_BAR; PG8_WAIT_L(0); PG8_MMA(0, 1, At, B1); PG8_BAR;
            PG8_LDA(At, 1, 1); PG8_STAGE(PG8_SA(1, 0), a3, voffA);
            PG8_BAR; PG8_WAIT_L(0); PG8_MMA(1, 0, At, B0); PG8_BAR; PG8_SCHED;
            PG8_STAGE(PG8_SB(1, 1), b3 + hstepB, voffB);
            PG8_WAIT_V(6); PG8_BAR; PG8_MMA(1, 1, At, B1); PG8_BAR;
            }
        }
        if constexpr (ALIGN_EPI) { if (wr == 0) PG8_BAR; }
        if constexpr (!Epi::AFTER_DRAIN) { int t2_ = threadIdx.x; asm volatile("" : "+v"(t2_)); E(acc, cur, wr, wc, t2_ & 15, (t2_ & 63) >> 4); S.done(cur); }
        if (!has_next) break;
#pragma unroll
        for (int a = 0; a < 2; ++a)
#pragma unroll
            for (int b = 0; b < 2; ++b)
#pragma unroll
                for (int m = 0; m < 4; ++m)
#pragma unroll
                    for (int n = 0; n < 2; ++n) acc[a][b][m][n] = (f32x4){0.f, 0.f, 0.f, 0.f};
        cur = nxt; cA = nA; cB = nB; ++ui;
        if constexpr (ALIGN_EPI) { if (wr == 1) PG8_BAR; }
    }
    PG8_WAIT_V(0);
    if constexpr (!ALIGN_EPI) { if (wr == 0) PG8_BAR; }
    PG8_BAR;
    if constexpr (Epi::AFTER_DRAIN) { E.fused(acc, cur, wr, wc, fr, fq, lds, wid, lane); S.done(cur); }
#undef PG8_SA
#undef PG8_SB
#undef PG8_STAGE
#undef PG8_LDA
#undef PG8_LDB
#undef PG8_MMA
#undef PG8_WAIT_V
#undef PG8_WAIT_L
#undef PG8_BAR
#undef PG8_SCHED
}
}
namespace att {
#define ALAS __attribute__((address_space(3)))
typedef unsigned short bf16_t;
typedef short bf16x8 __attribute__((ext_vector_type(8)));
typedef short s16x4 __attribute__((ext_vector_type(4)));
typedef float f32x16 __attribute__((ext_vector_type(16)));
typedef float f32x4 __attribute__((ext_vector_type(4)));
typedef unsigned u32x4 __attribute__((ext_vector_type(4)));
constexpr int NW = 8, QBLK = 32, KVBLK = 64, QB = 256;
constexpr int KROW = 400;
constexpr int SHM_V = KVBLK * VD * 2, SHM_K = KVBLK * KROW;
constexpr int LDS_V = 0, LDS_K = 2 * SHM_V, LDS_WS = LDS_K + 2 * SHM_K, LDS_BYTES = LDS_WS + NW * 64 * 4;
constexpr float SCALE = 0.07216878364870323f;
constexpr float THR = 8.f;
#define SBAR() __builtin_amdgcn_sched_barrier(0)
__device__ __forceinline__ int v_st(int k, int c) { const int kk = (k & ~0xC) | ((k & 4) << 1) | ((k & 8) >> 1); return ((kk >> 3) * 4 + (c >> 5)) * 512 + ((kk & 7) * 32 + (c & 31)) * 2; }
__device__ __forceinline__ int v_rd_base(int lane) { return ((lane & 3) << 3) | (((lane >> 2) & 3) << 6) | (((lane >> 4) & 1) << 5) | (((lane >> 5) & 1) << 8); }
constexpr int v_rd_off(int d0, int ks, int half) { return d0 * 512 + ks * 4096 + half * 2048; }
__device__ __forceinline__ int crow(int r, int hi) { return (r & 3) + 8 * (r >> 2) + 4 * hi; }
__device__ __forceinline__ unsigned cvtpk(float lo, float hi) { unsigned r; asm volatile("v_cvt_pk_bf16_f32 %0, %1, %2" : "=v"(r) : "v"(lo), "v"(hi)); return r; }
__device__ __forceinline__ void mask_tile(f32x16& p0, f32x16& p1, int dq) {
    const float NEG = -__builtin_inff();
#pragma unroll
    for (int r = 0; r < 16; ++r) { const int c = (r & 3) + 8 * (r >> 2); if (dq - c < 0) p0[r] = NEG; if (dq - c - 32 < 0) p1[r] = NEG; }
}
__device__ __forceinline__ void partialSM(f32x16& p0, f32x16& p1, float& m_reg, float& mn, float& alpha) {
    float pmax = p0[0];
#pragma unroll
    for (int r = 1; r < 16; ++r) pmax = fmaxf(pmax, p0[r]);
#pragma unroll
    for (int r = 0; r < 16; ++r) pmax = fmaxf(pmax, p1[r]);
    { auto rr = __builtin_amdgcn_permlane32_swap(__float_as_uint(pmax), __float_as_uint(pmax), false, false); pmax = fmaxf(__uint_as_float(rr[0]), __uint_as_float(rr[1])); }
    constexpr float C2 = 1.4426950408889634f * SCALE;
    if (__builtin_expect(__all((pmax - m_reg) * SCALE <= THR), 1)) { mn = m_reg; alpha = 1.f; }
    else { mn = fmaxf(m_reg, pmax); alpha = __builtin_amdgcn_exp2f((m_reg - mn) * C2); m_reg = mn; }
    const float mnL = -mn * C2;
#pragma unroll
    for (int r = 0; r < 16; ++r) p0[r] = fmaf(p0[r], C2, mnL);
#pragma unroll
    for (int r = 0; r < 16; ++r) p1[r] = fmaf(p1[r], C2, mnL);
#pragma unroll
    for (int r = 0; r < 16; ++r) p0[r] = __builtin_amdgcn_exp2f(p0[r]);
}
__device__ __forceinline__ void finishSM(f32x16& p0, f32x16& p1, float alpha, float& l_reg, bf16x8& pa0, bf16x8& pa1, bf16x8& pa2, bf16x8& pa3) {
#pragma unroll
    for (int r = 0; r < 16; ++r) p1[r] = __builtin_amdgcn_exp2f(p1[r]);
    float ps = 0;
#pragma unroll
    for (int r = 0; r < 16; ++r) ps += p0[r];
#pragma unroll
    for (int r = 0; r < 16; ++r) ps += p1[r];
    { auto rr = __builtin_amdgcn_permlane32_swap(__float_as_uint(ps), __float_as_uint(ps), false, false); ps = __uint_as_float(rr[0]) + __uint_as_float(rr[1]); }
    l_reg = l_reg * alpha + ps;
#define PK4(P, B_, OUT) do { unsigned a0 = cvtpk(P[B_+0], P[B_+1]), a1 = cvtpk(P[B_+2], P[B_+3]);                          \
        unsigned b0 = cvtpk(P[B_+4], P[B_+5]), b1 = cvtpk(P[B_+6], P[B_+7]);                                             \
        auto r0 = __builtin_amdgcn_permlane32_swap(a0, b0, false, false); auto r1 = __builtin_amdgcn_permlane32_swap(a1, b1, false, false); \
        u32x4 w = {r0[0], r1[0], r0[1], r1[1]}; OUT = *reinterpret_cast<bf16x8*>(&w); } while (0)
    PK4(p0, 0, pa0); PK4(p0, 8, pa1); PK4(p1, 0, pa2); PK4(p1, 8, pa3);
#undef PK4
}
#ifndef QK_DEPTH
#define QK_DEPTH 6
#endif
template <int KB>
__device__ __forceinline__ void qkt(f32x16& p0, f32x16& p1, const ALAS char* kb, const bf16x8* qr) {
    p0 = f32x16{}; p1 = f32x16{};
#define KRD(f) (*(const ALAS bf16x8*)(kb + KB * SHM_K + ((f) >> 1) * 32 + ((f) & 1) * 32 * KROW))
    bf16x8 kf[QK_DEPTH];
#pragma unroll
    for (int f = 0; f < QK_DEPTH; ++f) kf[f] = KRD(f);
    SBAR();
#pragma unroll
    for (int f = 0; f < 24; ++f) {
        if (f & 1) p1 = __builtin_amdgcn_mfma_f32_32x32x16_bf16(kf[f % QK_DEPTH], qr[f >> 1], p1, 0, 0, 0);
        else       p0 = __builtin_amdgcn_mfma_f32_32x32x16_bf16(kf[f % QK_DEPTH], qr[f >> 1], p0, 0, 0, 0);
        if (f + QK_DEPTH < 24) kf[f % QK_DEPTH] = KRD(f + QK_DEPTH);
        SBAR();
    }
#undef KRD
}
template <int VB>
__device__ __forceinline__ void pv_tile(f32x16* o, int vb0, bf16x8 pa0, bf16x8 pa1, bf16x8 pa2, bf16x8 pa3) {
#define TRRD(dst, off) asm volatile("ds_read_b64_tr_b16 %0, %1 offset:%2" : "=&v"(dst) : "v"(vb0), "i"(off) : "memory")
#define PV_D0(d0) do { s16x4 l0, l1, l2, l3, h0, h1, h2, h3; constexpr int b_ = VB * SHM_V + v_rd_off(d0, 0, 0); \
        TRRD(l0, b_); TRRD(h0, b_ + 2048); TRRD(l1, b_ + 4096); TRRD(h1, b_ + 6144); TRRD(l2, b_ + 8192); TRRD(h2, b_ + 10240); TRRD(l3, b_ + 12288); TRRD(h3, b_ + 14336); \
        asm volatile("s_waitcnt lgkmcnt(0)" ::: "memory"); SBAR(); \
        o[d0] = __builtin_amdgcn_mfma_f32_32x32x16_bf16(pa0, (bf16x8){l0[0], l0[1], l0[2], l0[3], h0[0], h0[1], h0[2], h0[3]}, o[d0], 0, 0, 0);   \
        o[d0] = __builtin_amdgcn_mfma_f32_32x32x16_bf16(pa1, (bf16x8){l1[0], l1[1], l1[2], l1[3], h1[0], h1[1], h1[2], h1[3]}, o[d0], 0, 0, 0);   \
        o[d0] = __builtin_amdgcn_mfma_f32_32x32x16_bf16(pa2, (bf16x8){l2[0], l2[1], l2[2], l2[3], h2[0], h2[1], h2[2], h2[3]}, o[d0], 0, 0, 0);   \
        o[d0] = __builtin_amdgcn_mfma_f32_32x32x16_bf16(pa3, (bf16x8){l3[0], l3[1], l3[2], l3[3], h3[0], h3[1], h3[2], h3[3]}, o[d0], 0, 0, 0); } while (0)
    PV_D0(0); PV_D0(1); PV_D0(2); PV_D0(3);
#undef PV_D0
#undef TRRD
}
__device__ __forceinline__ float silu_f(float v) { return v * __builtin_amdgcn_rcpf(1.0f + __builtin_amdgcn_exp2f(-1.4426950408889634f * v)); }

__device__ __forceinline__ void attn_block(const bf16_t* __restrict__ Qh, const bf16_t* __restrict__ Kh, const bf16_t* __restrict__ Vh, int qb,
                                           bf16_t* __restrict__ mixp, const bf16_t* __restrict__ zg, ALAS char* lds) {
    int tid_ = threadIdx.x; asm volatile("" : "+v"(tid_));
    const int tid = tid_, wid = __builtin_amdgcn_readfirstlane(tid >> 6), lane = tid & 63, r32 = lane & 31, hi = lane >> 5;
    const int NT = 4 * (qb + 1);
    const int qlo = qb * QB + wid * QBLK, qm = qlo + r32 - 4 * hi;
    ALAS char* V_lds = lds + LDS_V; ALAS char* K_lds = lds + LDS_K;
    ALAS float* ws = (ALAS float*)(lds + LDS_WS) + wid * 64; ALAS float* li_l = ws; ALAS float* al_l = ws + 32;
    float m_reg = -1e30f, l_reg = 0; f32x16 o[4] = {};
    const int sr = tid >> 4, sc = (tid & 15) * 8, vst0 = v_st(sr, sc), vst1 = v_st(32 + sr, sc);
    int kld[3];
#pragma unroll
    for (int i = 0; i < 3; ++i) { const int ci = tid + 512 * i; kld[i] = (ci / 24) * KROW + (ci % 24) * 16; }
    const int vb0 = (int)(unsigned)(uintptr_t)V_lds + v_rd_base(lane);
    const ALAS char* kb = K_lds + r32 * KROW + hi * 16;
    bf16x8 qr[12];
#pragma unroll
    for (int d0 = 0; d0 < 12; ++d0) qr[d0] = *(const bf16x8*)((const char*)Qh + (unsigned)(((qlo + r32) * QKD + d0 * 16 + hi * 8) * 2));
    bf16x8 st_v0, st_v1, st_k0, st_k1, st_k2;
    const unsigned vof0 = (unsigned)((sr * VD + sc) * 2), vof1 = vof0 + 32 * VD * 2, kof0 = (unsigned)tid * 16u, kof1 = kof0 + 8192u, kof2 = kof0 + 16384u;
#define SLOAD(t) do { const char* vt_ = (const char*)Vh + (size_t)(t) * (KVBLK * VD * 2); const char* kt_ = (const char*)Kh + (size_t)(t) * (KVBLK * QKD * 2); \
        st_v0 = *(const bf16x8*)(vt_ + vof0); st_v1 = *(const bf16x8*)(vt_ + vof1); st_k0 = *(const bf16x8*)(kt_ + kof0); st_k1 = *(const bf16x8*)(kt_ + kof1); st_k2 = *(const bf16x8*)(kt_ + kof2); } while (0)
#define SWRITE(bf) do { *(ALAS bf16x8*)(V_lds + (bf) * SHM_V + vst0) = st_v0; *(ALAS bf16x8*)(V_lds + (bf) * SHM_V + vst1) = st_v1; \
        *(ALAS bf16x8*)(K_lds + (bf) * SHM_K + kld[0]) = st_k0; *(ALAS bf16x8*)(K_lds + (bf) * SHM_K + kld[1]) = st_k1; *(ALAS bf16x8*)(K_lds + (bf) * SHM_K + kld[2]) = st_k2; } while (0)
#define RESC(a) do { if (__any((a) < 1.f)) { if (hi == 0) al_l[r32] = (a); asm volatile("s_waitcnt lgkmcnt(0)" ::: "memory");              \
                     _Pragma("unroll") for (int d_ = 0; d_ < 4; ++d_) _Pragma("unroll") for (int r = 0; r < 16; ++r) o[d_][r] *= al_l[crow(r, hi)]; } } while (0)
#define MASKT(P0_, P1_, t) do { const int kb_ = (t) * KVBLK; if (kb_ + KVBLK - 1 > qlo) mask_tile(P0_, P1_, qm - kb_); } while (0)
    f32x16 p0, p1; float mn, al; bf16x8 pa0, pa1, pa2, pa3;
    SLOAD(0); SWRITE(0); SLOAD(1);
    __syncthreads();
#define STEP(t, KB) do { if ((t) + 1 < NT) { SWRITE(1 - KB); } if ((t) + 2 < NT) { SLOAD((t) + 2); } SBAR();            \
        qkt<KB>(p0, p1, kb, qr); MASKT(p0, p1, (t)); partialSM(p0, p1, m_reg, mn, al); RESC(al);                       \
        finishSM(p0, p1, al, l_reg, pa0, pa1, pa2, pa3); SBAR(); pv_tile<KB>(o, vb0, pa0, pa1, pa2, pa3);               \
        __syncthreads(); } while (0)
    for (int t = 0; t < NT; t += 2) { STEP(t, 0); STEP(t + 1, 1); }
#undef STEP
    if (hi == 0) li_l[r32] = l_reg; asm volatile("s_waitcnt lgkmcnt(0)" ::: "memory");
    { int le = lane; asm volatile("" : "+v"(le));
      const int r32e = le & 31, hie = le >> 5;
      ALAS char* stg = lds + wid * 8192;
#pragma unroll
      for (int r = 0; r < 16; ++r) { const int orow = crow(r, hie); const float rl = __builtin_amdgcn_rcpf(li_l[orow]);
#pragma unroll
          for (int d0 = 0; d0 < 4; ++d0) { const float v = o[d0][r] * rl; const float vn = xshfl<1>(v);
              if ((r32e & 1) == 0) *(ALAS unsigned*)(stg + orow * 256 + (d0 * 32 + r32e) * 2) = cvtpk(v, vn); } }
      asm volatile("s_waitcnt lgkmcnt(0)" ::: "memory");
#pragma unroll
      for (int i = 0; i < 8; ++i) { const int c = le + 64 * i, row = c >> 4, ch = c & 15;
          const u32x4 ov = *(const ALAS u32x4*)(stg + row * 256 + ch * 16);
          const u32x4 gz = *(const u32x4*)((const char*)zg + (unsigned)(((qlo + row) * INC + ch * 8) * 2));
#define GM(O_, G_) cvtpk(__uint_as_float((O_) << 16) * silu_f(__uint_as_float((G_) << 16)), __uint_as_float((O_) & 0xffff0000u) * silu_f(__uint_as_float((G_) & 0xffff0000u)))
          u32x4 w; w.x = GM(ov.x, gz.x); w.y = GM(ov.y, gz.y); w.z = GM(ov.z, gz.z); w.w = GM(ov.w, gz.w);
#undef GM
          *(u32x4*)((char*)mixp + (unsigned)(((qlo + row) * DM + ch * 8) * 2)) = w; } }
    __syncthreads();
#undef SLOAD
#undef SWRITE
#undef RESC
#undef MASKT
}
#undef SBAR
}
#define LAS __attribute__((address_space(3)))
#define CAS __attribute__((address_space(4)))
typedef unsigned short bf16_t;
typedef float f32x4 __attribute__((ext_vector_type(4)));
typedef float f32x2 __attribute__((ext_vector_type(2)));
typedef unsigned u32x4 __attribute__((ext_vector_type(4)));
typedef unsigned u32x2 __attribute__((ext_vector_type(2)));
using pg8::cvt_pk_bf16; using pg8::bf_lo; using pg8::bf_hi; using pg8::fast_silu;

constexpr int NWAVES = 8, NTHREADS = 512;
constexpr int RING_BYTES = 131072, EXCH_OFF = RING_BYTES, BST_OFF = EXCH_OFF + 8192, LDS_BYTES = BST_OFF + 64;
constexpr int PH_PER_LAYER = 5, N_PHASES = 1 + PH_PER_LAYER * DEPTH;
#ifndef EN_P0
#define EN_P0 1
#endif
#ifndef EN_A
#define EN_A 1
#endif
#ifndef EN_B
#define EN_B 1
#endif
#ifndef EN_C1
#define EN_C1 1
#endif
#ifndef EN_C2
#define EN_C2 1
#endif
#ifndef EN_D
#define EN_D 1
#endif
#ifndef EN_E
#define EN_E 1
#endif
#ifndef EN_ATT
#define EN_ATT 1
#endif
#ifndef EN_PW
#define EN_PW 1
#endif
#ifndef REP_P0
#define REP_P0 1
#endif
#ifndef REP_A
#define REP_A 1
#endif
#ifndef REP_B
#define REP_B 1
#endif
#ifndef REP_C1
#define REP_C1 1
#endif
#ifndef REP_C2
#define REP_C2 1
#endif
#ifndef REP_ATT
#define REP_ATT 1
#endif
#ifndef REP_PW
#define REP_PW 1
#endif
#ifndef REP_E0
#define REP_E0 1
#endif
#ifndef REP_LAT
#define REP_LAT 1
#endif
#ifndef REP_CONV
#define REP_CONV 1
#endif
#ifndef REP_GEMV
#define REP_GEMV 1
#endif
#ifndef REP_CVT
#define REP_CVT 1
#endif
#ifndef WGM_B
#define WGM_B 5
#endif
#ifndef WGM_E
#define WGM_E 2
#endif
#ifndef WGM_QK
#define WGM_QK 8
#endif
#ifndef WGM_V
#define WGM_V 4
#endif
#ifndef WGM_PW
#define WGM_PW 4
#endif
#ifndef MK_ONE_LAUNCH
#define MK_ONE_LAUNCH 1
#endif

constexpr size_t MiB = 1u << 20;
constexpr size_t WS_MOD = 1 * MiB;
constexpr size_t WS_BIAS = WS_MOD + 256 * 1024;
constexpr size_t WS_COS = 2 * MiB, WS_SIN = 4 * MiB;
constexpr size_t WS_WIN = 6 * MiB;
constexpr size_t WS_WQ = 46 * MiB;
constexpr size_t WS_WK = 50 * MiB;
constexpr size_t WS_WV = 53 * MiB;
constexpr size_t WS_WPW = 54 * MiB;
constexpr size_t WS_WOUT = 58 * MiB;
constexpr size_t WS_H = 74 * MiB;
constexpr size_t WS_Z = 138 * MiB;
constexpr size_t WS_SSQ = 292 * MiB;
constexpr size_t WS_Q = 320 * MiB, WS_K = 368 * MiB;
constexpr size_t WS_V = 416 * MiB;
constexpr size_t WS_U2 = 448 * MiB;
constexpr size_t WS_END = 480 * MiB;

__device__ __forceinline__ float fast_sigmoid(float v) { return __builtin_amdgcn_rcpf(1.0f + __builtin_amdgcn_exp2f(-1.4426950408889634f * v)); }

#define XB_TMO      128
#define XB_XCNT(j)  (256  + 64 * (j))
#define XB_XSUB(j)  (1280 + 64 * (j))
#define XB_XGEN(j)  (2304 + 64 * (j))
#define XB_TOP      3328
#define XB_TOPGEN   3392
#define XCD_BAR_WORDS 3456
#define XB_SPIN_CAP (1u << 18)

__device__ __forceinline__ unsigned xb_ld(unsigned* p)              { return __hip_atomic_load(p, __ATOMIC_RELAXED, __HIP_MEMORY_SCOPE_AGENT); }
__device__ __forceinline__ unsigned xb_add(unsigned* p, unsigned v) { return __hip_atomic_fetch_add(p, v, __ATOMIC_RELAXED, __HIP_MEMORY_SCOPE_AGENT); }
__device__ __forceinline__ unsigned xb_xcc_id() { return (unsigned)__builtin_amdgcn_s_getreg((3 << 11) | 20) & 0xFu; }
#define XB_SPIN(cond, bar) do { unsigned _sp = 0; while (cond) { __builtin_amdgcn_s_sleep(1); \
    if ((++_sp & 255u) == 0u) { if (xb_ld(&(bar)[XB_TMO])) break; if (_sp > XB_SPIN_CAP) { atomicAdd(&(bar)[XB_TMO], 1u); break; } } } } while (0)

struct XcdBarrier {
    unsigned* bar; unsigned x;
    volatile LAS unsigned* st;
};

__device__ __forceinline__ XcdBarrier xcd_barrier_post(unsigned* bar, volatile LAS unsigned* st) {
    XcdBarrier b; b.bar = bar; b.x = xb_xcc_id(); b.st = st;
    if (threadIdx.x == 0) (void)xb_add(&bar[XB_XCNT(b.x)], 1u);
    return b;
}
__device__ __forceinline__ void xcd_barrier_complete(unsigned* bar, unsigned x, unsigned& nloc, unsigned& nx) {
    const unsigned G = gridDim.x * gridDim.y * gridDim.z;
    unsigned sum, cnt, mine, sp = 0u;
    for (;;) {
        sum = 0u; cnt = 0u; mine = 0u;
#pragma unroll
        for (unsigned j = 0; j < 16; ++j) { const unsigned c = xb_ld(&bar[XB_XCNT(j)]); sum += c; cnt += (c > 0u) ? 1u : 0u; mine = (j == x) ? c : mine; }
        if (sum == G) break;
        __builtin_amdgcn_s_sleep(1);
        if ((++sp & 255u) == 0u) { if (xb_ld(&bar[XB_TMO])) break; if (sp > XB_SPIN_CAP) { atomicAdd(&bar[XB_TMO], 1u); break; } }
    }
    nloc = mine > 0u ? mine : 1u; nx = cnt > 0u ? cnt : 1u;
}

__device__ __forceinline__ void xcd_barrier(const XcdBarrier& b) {
    asm volatile("s_waitcnt vmcnt(0)" ::: "memory");
    __syncthreads();
    if (threadIdx.x == 0) {
        unsigned* bar = b.bar;
        __builtin_amdgcn_s_waitcnt(0);
        unsigned nloc = b.st[0], nx = b.st[1];
        if (nloc == 0u) { xcd_barrier_complete(bar, b.x, nloc, nx); b.st[0] = nloc; b.st[1] = nx; }
        const unsigned old = xb_add(&bar[XB_XSUB(b.x)], 1u);
        const unsigned gen = old / nloc;
        if (old + 1u == (gen + 1u) * nloc) {
            __builtin_amdgcn_fence(__ATOMIC_RELEASE, "agent");
            asm volatile("s_waitcnt vmcnt(0)" ::: "memory");
            const unsigned og = xb_add(&bar[XB_TOP], 1u);
            const unsigned tg = og / nx;
            if (og + 1u == (tg + 1u) * nx) xb_add(&bar[XB_TOPGEN], 1u);
            else XB_SPIN(xb_ld(&bar[XB_TOPGEN]) == tg, bar);
            __builtin_amdgcn_fence(__ATOMIC_ACQUIRE, "agent");
            xb_add(&bar[XB_XGEN(b.x)], 1u);
            asm volatile("s_waitcnt vmcnt(0)" ::: "memory");
        } else {
            XB_SPIN(xb_ld(&bar[XB_XGEN(b.x)]) == gen, bar);
            __builtin_amdgcn_fence(__ATOMIC_ACQUIRE, "agent");
            asm volatile("s_waitcnt vmcnt(0)" ::: "memory");
        }
    }
    __syncthreads();
}

__device__ __forceinline__ int hmap(int c) {
    if (c < 128) return c;
    if (c >= 192) return -1;
    const int q = c - 128, wc = q >> 5, fq = (q >> 3) & 3, n = (q >> 2) & 1, j = q & 3;
    return 128 + 32 * n + 16 * wc + 4 * fq + j;
}
__device__ __forceinline__ void cvt_load(float (&v)[32], const float* __restrict__ W, const float* __restrict__ gk, int Nsrc, int Ksrc, int col, int idk, int k0, int lane) {
#pragma unroll
    for (int i = 0; i < 32; ++i) { const int k = k0 + 2 * i + (lane >> 5); float x = 0.f;
        if (col >= 0 && k < Ksrc) { x = __builtin_nontemporal_load(W + (size_t)k * Nsrc + col); if (gk) x *= gk[k]; }
        if (k == idk) x = 1.f;
        v[i] = x; }
}
__device__ __forceinline__ void cvt_store(const float (&v)[32], bf16_t* __restrict__ WT, int Kout, int n0, int k0, LAS float* scr, int lane) {
#pragma unroll
    for (int i = 0; i < 32; ++i) scr[(2 * i + (lane >> 5)) * 33 + (lane & 31)] = v[i];
    asm volatile("s_waitcnt lgkmcnt(0)" ::: "memory");
    const int c = lane & 7;
#pragma unroll
    for (int j = 0; j < 4; ++j) { const int n = (lane >> 3) + 8 * j; const LAS float* s = scr + (8 * c) * 33 + n;
        u32x4 o; o.x = cvt_pk_bf16(s[0 * 33], s[1 * 33]); o.y = cvt_pk_bf16(s[2 * 33], s[3 * 33]); o.z = cvt_pk_bf16(s[4 * 33], s[5 * 33]); o.w = cvt_pk_bf16(s[6 * 33], s[7 * 33]);
        *(u32x4*)(WT + (size_t)(n0 + n) * Kout + k0 + 8 * c) = o; }
    asm volatile("s_waitcnt lgkmcnt(0)" ::: "memory");
}
struct CvtDst { bf16_t* WT; int Kout, n0, k0; };

template <int SI> __device__ __forceinline__ void conv_step(f32x2 (&av)[32], const f32x2 (&wv)[CK], const f32x2 u) {
#pragma unroll
    for (int tt = 0; tt < 32; ++tt) { const int j = SI - tt; if (j >= 0 && j <= 30) av[tt] = wv[j] * u + av[tt]; }
}

struct Args { const float* in[21]; float* out; unsigned char* ws; int ph_lo, ph_hi; };

__global__ void __launch_bounds__(NTHREADS, 2) mk_fwd(Args a) {
    extern __shared__ __attribute__((aligned(16))) unsigned char lds_raw[];
    LAS unsigned char* lds = (LAS unsigned char*)lds_raw;
    cg::grid_group grid = cg::this_grid();
    const int lo = a.ph_lo, hi = a.ph_hi;
    volatile LAS unsigned* bst = (volatile LAS unsigned*)(lds + BST_OFF);
    if (threadIdx.x < 2) bst[threadIdx.x] = 0u;
    __syncthreads();
    XcdBarrier xbar; xbar.bar = (unsigned*)a.ws; xbar.x = 0; xbar.st = bst;
    if (hi - lo > 1) xbar = xcd_barrier_post((unsigned*)a.ws, bst);
#define PHASE_BEGIN() \
    const CAS Args* ap = (const CAS Args*)__builtin_amdgcn_kernarg_segment_ptr(); asm volatile("" : "+s"(ap)); \
    int tid = threadIdx.x; asm volatile("" : "+v"(tid)); \
    const int lane = tid & 63, wave = __builtin_amdgcn_readfirstlane(tid >> 6); \
    int G = gridDim.x, bx = blockIdx.x; asm volatile("" : "+s"(G), "+s"(bx)); \
    const int gw = bx * NWAVES + wave, NGW = G * NWAVES; \
    unsigned char* ws = ap->ws; (void)lane; (void)gw; (void)NGW; (void)ws;
#define INP(i) (ap->in[i])
#define IN(k) (lo <= (k) && (k) < hi)
#ifndef USE_CG_SYNC
#define USE_CG_SYNC 0
#endif
#define SEAM(k) do { if (IN(k) && IN((k) + 1)) { if (USE_CG_SYNC || (k) == 0) grid.sync(); else xcd_barrier(xbar); } } while (0)

    for (int rep_ = 0; rep_ < REP_P0; ++rep_) if (EN_P0 && IN(0)) {
        PHASE_BEGIN();
        const float* c_in = INP(1); const int* positions = (const int*)INP(2); const float* ada_w = INP(3); const float* ada_b = INP(4); const float* w_in = INP(6);
        const float* w_q_up = INP(8); const float* w_kv_up = INP(10); const float* q_lat_g = INP(7); const float* kv_lat_g = INP(9); const float* glu_b = INP(13); const float* w_pw = INP(18); const float* w_out = INP(20);
        float* modb = (float*)(ws + WS_MOD); float* biasb = (float*)(ws + WS_BIAS); float* cosb = (float*)(ws + WS_COS); float* sinb = (float*)(ws + WS_SIN);
        bf16_t* Win_t = (bf16_t*)(ws + WS_WIN); bf16_t* Wq_t = (bf16_t*)(ws + WS_WQ); bf16_t* Wk_t = (bf16_t*)(ws + WS_WK); bf16_t* Wv_t = (bf16_t*)(ws + WS_WV);
        bf16_t* Wpw_t = (bf16_t*)(ws + WS_WPW); bf16_t* Wout_t = (bf16_t*)(ws + WS_WOUT);
        LAS float* scl = (LAS float*)lds;
        LAS float* red = (LAS float*)(lds + 32768);
        { for (int i = tid; i < NB * DM; i += NTHREADS) { const int b = i / DM, k = i % DM; scl[k * 4 + b] = fast_silu(c_in[i]); } __syncthreads(); }
        for (int rg_ = 0; rg_ < REP_GEMV; ++rg_) for (int task = bx; task < 256; task += G) {
            const int l = task >> 7, col = (task & 127) * 48 + (lane < 48 ? lane : 47);
            const float* wp = ada_w + (size_t)l * DM * 6144 + (size_t)(wave * 256) * 6144 + col;
            float a0 = 0.f, a1 = 0.f, a2 = 0.f, a3 = 0.f;
#pragma unroll 64
            for (int k = 0; k < 256; ++k) { const float wv = __builtin_nontemporal_load(wp + (size_t)k * 6144); const f32x4 s = *(const LAS f32x4*)(scl + (wave * 256 + k) * 4);
                a0 += s[0] * wv; a1 += s[1] * wv; a2 += s[2] * wv; a3 += s[3] * wv; }
            red[(wave * 4 + 0) * 64 + lane] = a0; red[(wave * 4 + 1) * 64 + lane] = a1; red[(wave * 4 + 2) * 64 + lane] = a2; red[(wave * 4 + 3) * 64 + lane] = a3;
            __syncthreads();
            if (tid < 256) { const int b = tid >> 6; float s = 0.f;
#pragma unroll
                for (int w = 0; w < 8; ++w) s += red[(w * 4 + b) * 64 + lane];
                if (lane < 48) modb[(size_t)(l * NB + b) * 6144 + col] = s + ada_b[l * 6144 + col]; }
            __syncthreads();
        }
        for (int i = bx * NTHREADS + tid; i < T * 32; i += G * NTHREADS) { const int t = i >> 5, j = i & 31;
            const float inv = 1.0f / powf(10000.0f, (float)(2 * j) * (1.0f / 64.0f)); const float ang = (float)positions[t] * inv;
            cosb[i] = cosf(ang); sinb[i] = sinf(ang); }
        for (int i = bx * NTHREADS + tid; i < DEPTH * INCP; i += G * NTHREADS) { const int l = i / INCP, c = i % INCP;
            biasb[i] = (c >= Z_CV && c < Z_CG) ? glu_b[l * 2048 + (c - Z_CV)] : 0.f; }
        {
            LAS float* scr = (LAS float*)(lds + 40960 + wave * 8448);
            constexpr int I0 = 5120, I1 = I0 + 512, I2 = I1 + 384, I3 = I2 + 128, I4 = I3 + 512, I5 = I4 + 2048;
            float va[32], vb[32]; CvtDst da, db;
#define CVT_ISSUE(IT, V, D) { const int it = (IT); \
                const int l = it / I5; int r = it % I5; \
                const float* W; int Nsrc, Ksrc, Kout, nN; bf16_t* WT; int mat; \
                if (r < I0) { mat = 0; W = w_in + (size_t)l * DM * INC; Nsrc = INC; Ksrc = DM; Kout = DM; nN = INCP / 32; WT = Win_t + (size_t)l * INCP * DM; } \
                else if (r < I1) { r -= I0; mat = 1; W = w_q_up + (size_t)l * QL * 1536; Nsrc = 1536; Ksrc = QL; Kout = KQ; nN = 64; WT = Wq_t + (size_t)l * 2048 * KQ; } \
                else if (r < I2) { r -= I1; mat = 2; W = w_kv_up + (size_t)l * KVL * 2048; Nsrc = 2048; Ksrc = KVL; Kout = KK; nN = 64; WT = Wk_t + (size_t)l * 2048 * KK; } \
                else if (r < I3) { r -= I2; mat = 3; W = w_kv_up + (size_t)l * KVL * 2048; Nsrc = 2048; Ksrc = KVL; Kout = KV; nN = 32; WT = Wv_t + (size_t)l * 1024 * KV; } \
                else if (r < I4) { r -= I3; mat = 4; W = w_pw + (size_t)l * DC * DC; Nsrc = DC; Ksrc = DC; Kout = DC; nN = 32; WT = Wpw_t + (size_t)l * DC * DC; } \
                else { r -= I4; mat = 5; W = w_out + (size_t)l * DM * DM; Nsrc = DM; Ksrc = DM; Kout = DM; nN = 64; WT = Wout_t + (size_t)l * DM * DM; } \
                const int kb = r / nN, nb = r % nN, n0 = nb * 32, k0 = kb * 64, n = n0 + (lane & 31); \
                int col = n, idk = -1; \
                if (mat == 0) col = n < INC ? n : -1; \
                else if (mat == 1) { const int hc = hmap(n & 255); col = hc >= 0 ? (n >> 8) * QKD + hc : -1; } \
                else if (mat == 2) { const int hc = hmap(n & 255); if (hc < 0) col = -1; else if (hc < 128) col = (n >> 8) * 256 + hc; else { col = -1; idk = 256 + (hc - 128); } } \
                else if (mat == 3) col = (n >> 7) * 256 + 128 + (n & 127); \
                const float* gk = (mat == 1) ? q_lat_g + l * QL : (mat == 2 || mat == 3) ? kv_lat_g + l * KVL : nullptr; \
                D.WT = WT; D.Kout = Kout; D.n0 = n0; D.k0 = k0; cvt_load(V, W, gk, Nsrc, Ksrc, col, idk, k0, lane); }
            for (int rv_ = 0; rv_ < REP_CVT; ++rv_) {
                int it0 = gw;
                if (it0 < DEPTH * I5) CVT_ISSUE(it0, va, da)
                for (; it0 < DEPTH * I5; it0 += 2 * NGW) {
                    const bool hb = it0 + NGW < DEPTH * I5, ha = it0 + 2 * NGW < DEPTH * I5;
                    if (hb) CVT_ISSUE(it0 + NGW, vb, db)
                    cvt_store(va, da.WT, da.Kout, da.n0, da.k0, scr, lane);
                    if (ha) CVT_ISSUE(it0 + 2 * NGW, va, da)
                    if (hb) cvt_store(vb, db.WT, db.Kout, db.n0, db.k0, scr, lane);
                }
            }
#undef CVT_ISSUE
        }
    }
    SEAM(0);

#pragma unroll 1
    for (int l = 0; l < DEPTH; ++l) {
        const int pb = 1 + PH_PER_LAYER * l;
        for (int rep_ = 0; rep_ < REP_A; ++rep_) if (EN_A && IN(pb)) {
            PHASE_BEGIN();
            const float* xin = (l == 0) ? INP(0) : (const float*)ap->out; const float* mod_l = (const float*)(ws + WS_MOD) + (size_t)l * NB * 6144;
            bf16_t* Hb = (bf16_t*)(ws + WS_H);
            const float* g = INP(5) + l * DM;
            for (int row0 = gw * 8; row0 < T; row0 += NGW * 8) {
                const int b = row0 / SEQ;
                f32x4 gs[8], sh[8];
#pragma unroll
                for (int j = 0; j < 8; ++j) { const int col = 4 * lane + 256 * j; const f32x4 g4 = *(const f32x4*)(g + col), s4 = *(const f32x4*)(mod_l + b * 6144 + 2048 + col);
                    gs[j] = g4 * (1.0f + s4); sh[j] = *(const f32x4*)(mod_l + b * 6144 + col); }
#pragma unroll 2
                for (int r = 0; r < 8; ++r) { const float* xr = xin + (size_t)(row0 + r) * DM + 4 * lane; f32x4 v[8]; float ss = 0.f;
#pragma unroll
                    for (int j = 0; j < 8; ++j) { v[j] = __builtin_nontemporal_load((const f32x4*)(xr + 256 * j)); ss +=     (v[j][0] * v[j][0] + v[j][1] * v[j][1]) + (v[j][2] * v[j][2] + v[j][3] * v[j][3]); }
                    const float rinv = __builtin_amdgcn_rsqf(wave_sum(ss) * (1.0f / DM) + EPS);
                    bf16_t* hr = Hb + (size_t)(row0 + r) * DM + 4 * lane;
#pragma unroll
                    for (int j = 0; j < 8; ++j) { const f32x4 o = v[j] * rinv * gs[j] + sh[j]; u32x2 w; w.x = cvt_pk_bf16(o[0], o[1]); w.y = cvt_pk_bf16(o[2], o[3]); *(u32x2*)(hr + 256 * j) = w; } }
            }
        }
        SEAM(pb);
        for (int rep_ = 0; rep_ < REP_B; ++rep_) if (EN_B && IN(pb + 1)) {
            PHASE_BEGIN();
            bf16_t* Hb = (bf16_t*)(ws + WS_H); bf16_t* Zb = (bf16_t*)(ws + WS_Z); bf16_t* Win_t = (bf16_t*)(ws + WS_WIN); float* biasb = (float*)(ws + WS_BIAS);
            pg8::Gemm g{Hb, Win_t + (size_t)l * INCP * DM, T, INCP, DM, DM, DM}; pg8::StaticOrder S; { int bxo = bx; asm volatile("" : "+s"(bxo)); S.init(T, INCP, G, bxo, WGM_B); }
            pg8::EpiZ E{Zb, INC, biasb + l * INCP, INC, (float*)(ws + WS_SSQ)};
            pg8::gemm_phase<pg8::EpiZ, pg8::StaticOrder, true, true>(lds, g, S, E);
        }
        SEAM(pb + 1);
        for (int rep_ = 0; rep_ < REP_C2; ++rep_) if (EN_C2 && IN(pb + 2)) {
            PHASE_BEGIN();
            bf16_t* Zb = (bf16_t*)(ws + WS_Z); bf16_t* U2 = (bf16_t*)(ws + WS_U2); const float* ssq = (const float*)(ws + WS_SSQ);
            const float* dw_w = INP(14); const float* dw_b = INP(15); const float* conv_ln_g = INP(16); const float* conv_ln_b = INP(17);
            bf16_t* Qb = (bf16_t*)(ws + WS_Q); bf16_t* Kb = (bf16_t*)(ws + WS_K); bf16_t* Vb = (bf16_t*)(ws + WS_V);
            bf16_t* Wq_t = (bf16_t*)(ws + WS_WQ); bf16_t* Wk_t = (bf16_t*)(ws + WS_WK); bf16_t* Wv_t = (bf16_t*)(ws + WS_WV); float* cosb = (float*)(ws + WS_COS); float* sinb = (float*)(ws + WS_SIN);
            const float* q_norm_g = INP(11); const float* k_norm_g = INP(12);
            LAS float* P = (LAS float*)(lds + EXCH_OFF);
            { pg8::Gemm g{Zb, Wq_t + (size_t)l * 2048 * KQ, T, 2048, KQ, INC, KQ}; pg8::StaticOrder S; { int bxo = bx; asm volatile("" : "+s"(bxo)); S.init(T, 2048, G, bxo, WGM_QK); }
              pg8::EpiHead E{Qb, q_norm_g + l * QKD, cosb, sinb, P, ssq, 1};
              pg8::gemm_phase<pg8::EpiHead, pg8::StaticOrder, true, true>(lds, g, S, E); }
            { pg8::Gemm g{Zb + Z_KVL, Wk_t + (size_t)l * 2048 * KK, T, 2048, KK, INC, KK};     pg8::StaticOrder S; { int bxo = bx; asm volatile("" : "+s"(bxo)); S.init(T, 2048, G, bxo, WGM_QK); }
              pg8::EpiHead E{Kb, k_norm_g + l * QKD, cosb, sinb, P, ssq, 0};
              pg8::gemm_phase<pg8::EpiHead, pg8::StaticOrder, true, true>(lds, g, S, E); }
            { pg8::Gemm g{Zb + Z_KVL, Wv_t + (size_t)l * 1024 * KV, T, 1024, KV, INC, KV}; pg8::StaticOrder S; { int bxo = bx; asm volatile("" : "+s"(bxo)); S.init(T, 1024, G, bxo, WGM_V); }
              pg8::EpiV E{Vb, ssq};
              pg8::gemm_phase<pg8::EpiV, pg8::StaticOrder, true, true>(lds, g, S, E); }
            {
                LAS bf16_t* ubuf = (LAS bf16_t*)lds;
                LAS float* red = (LAS float*)(lds + 126976);
                const int c0 = 2 * tid;
                const float* dww = dw_w + (size_t)l * CK * DC;
                const int vcu_c = (G % 8 == 0) ? (bx % 8) * (G / 8) + bx / 8 : bx, ipb_c = (T / 32 + G - 1) / G;
                for (int rc_ = 0; rc_ < REP_CONV; ++rc_) for (int item = vcu_c * ipb_c; item < T / 32 && item < (vcu_c + 1) * ipb_c; ++item) {
                    const int t0 = item * 32, s0 = t0 % SEQ;
#pragma unroll 8
                    for (int itc = 0; itc < 16; ++itc) { const int ck = tid + NTHREADS * itc; if (ck < 62 * 128) { const int si = ck >> 7, c8 = (ck & 127) * 8; u32x4 o = {0u, 0u, 0u, 0u};
                        if (s0 - 30 + si >= 0) { const bf16_t* zr = Zb + (size_t)(t0 - 30 + si) * INC; const u32x4 vv = *(const u32x4*)(zr + Z_CV + c8), gg = *(const u32x4*)(zr + Z_CGL + c8);
                            o.x = cvt_pk_bf16(bf_lo(vv.x) * fast_sigmoid(bf_lo(gg.x)), bf_hi(vv.x) * fast_sigmoid(bf_hi(gg.x))); o.y = cvt_pk_bf16(bf_lo(vv.y) * fast_sigmoid(bf_lo(gg.y)), bf_hi(vv.y) * fast_sigmoid(bf_hi(gg.y)));
                            o.z = cvt_pk_bf16(bf_lo(vv.z) * fast_sigmoid(bf_lo(gg.z)), bf_hi(vv.z) * fast_sigmoid(bf_hi(gg.z))); o.w = cvt_pk_bf16(bf_lo(vv.w) * fast_sigmoid(bf_lo(gg.w)), bf_hi(vv.w) * fast_sigmoid(bf_hi(gg.w))); }
                        *(LAS u32x4*)(ubuf + si * DC + c8) = o; } }
                    __syncthreads();
                    f32x2 wv[CK];
#pragma unroll
                    for (int j = 0; j < CK; ++j) wv[j] = *(const f32x2*)(dww + j * DC + c0);
                    f32x2 av[32];
                    { const f32x2 bb = *(const f32x2*)(dw_b + l * DC + c0);
#pragma unroll
                      for (int tt = 0; tt < 32; ++tt) av[tt] = bb; }
#define CS(SI) { const unsigned uu = *(const LAS unsigned*)(ubuf + (SI) * DC + c0); conv_step<SI>(av, wv, (f32x2){bf_lo(uu), bf_hi(uu)}); }
                    CS(0) CS(1) CS(2) CS(3) CS(4) CS(5) CS(6) CS(7) CS(8) CS(9) CS(10) CS(11) CS(12) CS(13) CS(14) CS(15) CS(16) CS(17) CS(18) CS(19) CS(20) CS(21) CS(22) CS(23) CS(24) CS(25) CS(26) CS(27) CS(28) CS(29) CS(30) CS(31) CS(32) CS(33) CS(34) CS(35) CS(36) CS(37) CS(38) CS(39) CS(40) CS(41) CS(42) CS(43) CS(44) CS(45) CS(46) CS(47) CS(48) CS(49) CS(50) CS(51) CS(52) CS(53) CS(54) CS(55) CS(56) CS(57) CS(58) CS(59) CS(60) CS(61)
#undef CS
                    float v[64];
#pragma unroll
                    for (int tt = 0; tt < 32; ++tt) { v[tt] = av[tt][0] + av[tt][1]; v[32 + tt] = av[tt][0] * av[tt][0] + av[tt][1] * av[tt][1]; }
                    { const bool up = (lane & 32) != 0;
#pragma unroll
                      for (int i = 0; i < 32; ++i) { const float send = up ? v[i] : v[i + 32]; const float keep = up ? v[i + 32] : v[i]; v[i] = keep + xswap32(send, up); } }
#define TRED(STEP) { const bool up = (lane & STEP) != 0; _Pragma("unroll") for (int i = 0; i < STEP; ++i) { const float send = up ? v[i] : v[i + STEP]; const float keep = up ? v[i + STEP] : v[i]; v[i] = keep + xshfl<STEP>(send); } }
                    TRED(16) TRED(8) TRED(4) TRED(2) TRED(1)
#undef TRED
                    red[wave * 64 + lane] = v[0];
                    __syncthreads();
                    float tot = 0.f;
#pragma unroll
                    for (int w = 0; w < 8; ++w) tot += red[w * 64 + lane];
                    const float other = xswap32(tot, lane >= 32);
                    const float s1 = lane < 32 ? tot : other, s2 = lane < 32 ? other : tot;
                    const float mean = s1 * (1.0f / DC), var = s2 * (1.0f / DC) - mean * mean, rstd = __builtin_amdgcn_rsqf(var + EPS);
                    const f32x2 lg = *(const f32x2*)(conv_ln_g + l * DC + c0), lb = *(const f32x2*)(conv_ln_b + l * DC + c0);
#pragma unroll
                    for (int tt = 0; tt < 32; ++tt) { const float m = __int_as_float(__builtin_amdgcn_readlane(__float_as_int(mean), tt)), rs = __int_as_float(__builtin_amdgcn_readlane(__float_as_int(rstd), tt));
                        const float o0 = (av[tt][0] - m) * rs * lg[0] + lb[0], o1 = (av[tt][1] - m) * rs * lg[1] + lb[1];
                        *(unsigned*)(U2 + (size_t)(t0 + tt) * DC + c0) = cvt_pk_bf16(fast_silu(o0), fast_silu(o1)); }
                    __syncthreads();
                }
            }
        }
        SEAM(pb + 2);
        if (EN_D && IN(pb + 3)) {
            PHASE_BEGIN();
            bf16_t* Hb = (bf16_t*)(ws + WS_H); bf16_t* Zb = (bf16_t*)(ws + WS_Z); bf16_t* Qb = (bf16_t*)(ws + WS_Q); bf16_t* Kb = (bf16_t*)(ws + WS_K); bf16_t* Vb = (bf16_t*)(ws + WS_V);
            bf16_t* U2 = (bf16_t*)(ws + WS_U2); bf16_t* Wpw_t = (bf16_t*)(ws + WS_WPW); const float* b_pw = INP(19);
            const int vcu = (G % 8 == 0) ? (bx % 8) * (G / 8) + bx / 8 : bx;
            for (int rep_ = 0; rep_ < REP_ATT; ++rep_) for (int it = vcu; it < NB * NH * 8; it += G) {
                const int bh = it >> 3, xq = it & 7, b = bh / NH, h = bh % NH;
                const bf16_t* Qh = Qb + (size_t)bh * SEQ * QKD; const bf16_t* Kh = Kb + (size_t)bh * SEQ * QKD; const bf16_t* Vh = Vb + (size_t)bh * SEQ * VD;
                bf16_t* mixp = Hb + (size_t)b * SEQ * DM + h * VD; const bf16_t* zg = Zb + (size_t)b * SEQ * INC + Z_MG + h * VD;
#pragma unroll 1
                for (int pass = 0; pass < 2 * EN_ATT; ++pass) att::attn_block(Qh, Kh, Vh, pass ? xq : 15 - xq, mixp, zg, (LAS char*)lds);
            }
            for (int rep_ = 0; rep_ < REP_PW; ++rep_) if (EN_PW) { pg8::Gemm g{U2, Wpw_t + (size_t)l * DC * DC, T, DC, DC, DC, DC}; pg8::StaticOrder S; { int bxo = bx; asm volatile("" : "+s"(bxo)); S.init(T, DC, G, bxo, WGM_PW); }
              pg8::EpiPw E{Hb, Zb, b_pw + l * DC};
              pg8::gemm_phase<pg8::EpiPw, pg8::StaticOrder, true, true>(lds, g, S, E); }
        }
        SEAM(pb + 3);
        for (int rep_ = 0; rep_ < (l == 0 ? REP_E0 : 1); ++rep_) if (EN_E && IN(pb + 4)) {
            PHASE_BEGIN();
            bf16_t* Hb = (bf16_t*)(ws + WS_H); bf16_t* Wout_t = (bf16_t*)(ws + WS_WOUT);
            const float* xin = (l == 0) ? INP(0) : (const float*)ap->out; const float* mod_l = (const float*)(ws + WS_MOD) + (size_t)l * NB * 6144;
            pg8::Gemm g{Hb, Wout_t + (size_t)l * DM * DM, T, DM, DM, DM, DM}; pg8::StaticOrder S; { int bxo = bx; asm volatile("" : "+s"(bxo)); S.init(T, DM, G, bxo, WGM_E); }
            pg8::EpiOut E{xin, ap->out, mod_l + 4096, l == DEPTH - 1};
            pg8::gemm_phase<pg8::EpiOut, pg8::StaticOrder, true, true>(lds, g, S, E);
        }
        SEAM(pb + 4);
    }
#undef IN
#undef SEAM
}

extern "C" void kernel_launch(void* const* d_in, const int* in_sizes, int n_in, void* d_out, int out_size, void* d_ws, size_t ws_size, hipStream_t stream) {
    static int grid = 0;
    if (grid == 0) {
        if (n_in != 21 || in_sizes[0] != T * DM || out_size != T * DM || ws_size < WS_END) { fprintf(stderr, "kernel_launch: unexpected shapes (n_in %d, in0 %d, out %d, ws %zu)\n", n_in, n_in > 0 ? in_sizes[0] : -1, out_size, ws_size); grid = -1; return; }
        int dev = 0, cus = 0, per_cu = 0;
        (void)hipGetDevice(&dev); (void)hipDeviceGetAttribute(&cus, hipDeviceAttributeMultiprocessorCount, dev);
        if (hipFuncSetAttribute((const void*)mk_fwd, hipFuncAttributeMaxDynamicSharedMemorySize, LDS_BYTES) != hipSuccess) { fprintf(stderr, "kernel_launch: hipFuncSetAttribute failed\n"); grid = -1; return; }
        if (hipOccupancyMaxActiveBlocksPerMultiprocessor(&per_cu, (const void*)mk_fwd, NTHREADS, LDS_BYTES) != hipSuccess || per_cu < 1) { fprintf(stderr, "kernel_launch: occupancy query says %d blocks per CU\n", per_cu); per_cu = 1; }
        (void)hipGetLastError();
        grid = cus * 1;
        fprintf(stderr, "kernel_launch: %d CUs, occupancy %d, grid %d\n", cus, per_cu, grid);
    }
    if (grid < 0) return;
    Args a{};
    for (int i = 0; i < 21; ++i) a.in[i] = (const float*)d_in[i];
    a.out = (float*)d_out; a.ws = (unsigned char*)d_ws;
#if MK_ONE_LAUNCH
    (void)hipMemsetAsync(d_ws, 0, 16384, stream);
    a.ph_lo = 0; a.ph_hi = N_PHASES;
    void* args[] = {&a};
    hipError_t e = hipLaunchCooperativeKernel((const void*)mk_fwd, dim3(grid), dim3(NTHREADS), args, LDS_BYTES, stream);
    if (e != hipSuccess) fprintf(stderr, "kernel_launch: cooperative launch failed: %s (grid %d)\n", hipGetErrorString(e), grid);
#else
    for (int p = 0; p < N_PHASES; ++p) { a.ph_lo = p; a.ph_hi = p + 1; hipLaunchKernelGGL(mk_fwd, dim3(grid), dim3(NTHREADS), LDS_BYTES, stream, a); }
#endif
}
```

```cpp
#include <hip/hip_runtime.h>
#include <hip/hip_cooperative_groups.h>
#include <cstdio>
#include <cstdint>
namespace cg = cooperative_groups;

constexpr int DM = 2048, NB = 4, SEQ = 4096, T = NB * SEQ, DEPTH = 2;
constexpr int NH = 8, QKD = 192, VD = 128, QL = 512, KVL = 256, DC = 1024, CK = 31;
constexpr int INC = 4928, INCP = 5120;
constexpr int Z_KVL = 512, Z_KR = 768, Z_MG = 832, Z_CV = 1856, Z_CGL = 2880, Z_CG = 3904;
constexpr int KQ = 512, KK = 384, KV = 256;
constexpr float EPS = 1e-6f;

template <int K> __device__ __forceinline__ float xshfl(float v) { static_assert(K >= 1 && K < 32, "xshfl"); return __int_as_float(__builtin_amdgcn_ds_swizzle(__float_as_int(v), (K << 10) | 0x1f)); }
__device__ __forceinline__ float xsum32(float v) { auto rr = __builtin_amdgcn_permlane32_swap(__float_as_uint(v), __float_as_uint(v), false, false); return __uint_as_float(rr[0]) + __uint_as_float(rr[1]); }
__device__ __forceinline__ float xswap32(float v, bool upper) { auto rr = __builtin_amdgcn_permlane32_swap(__float_as_uint(v), __float_as_uint(v), false, false); return __uint_as_float(upper ? rr[0] : rr[1]); }
__device__ __forceinline__ float wave_sum(float v) { v += xshfl<1>(v); v += xshfl<2>(v); v += xshfl<4>(v); v += xshfl<8>(v); v += xshfl<16>(v); return xsum32(v); }
namespace pg8 {
#define PG8_LAS __attribute__((address_space(3)))
typedef unsigned short bf16_t;
typedef short bf16x8 __attribute__((ext_vector_type(8)));
typedef float f32x4 __attribute__((ext_vector_type(4)));
typedef unsigned u32x4 __attribute__((ext_vector_type(4)));
constexpr int BM = 256, BK = 64, HALF = 128, HTB = HALF * BK * 2  , STAGE_BYTES = 8 * HTB, NXCD = 8, WGM = 4;

__host__ __device__ __forceinline__ int lds_byte(int r, int c) { const int st = (r >> 4) * 2 + (c >> 5), rr = r & 15, cc = c & 31, ob = rr * 64 + cc * 2; return st * 1024 + (ob ^ (((ob >> 9) & 1) << 5)); }
__host__ __device__ __forceinline__ void stage_rc(int b, int& R, int& C) { const int st = b / 1024, sb = b % 1024, swz = sb ^ (((sb >> 9) & 1) << 5); R = (st >> 1) * 16 + swz / 64; C = (st & 1) * 32 + (swz % 64) / 2; }
__host__ __device__ __forceinline__ int perm32(int rho) { const int n = rho >> 4, i = rho & 15; return 8 * (i >> 2) + 4 * n + (i & 3); }

struct Unit { int pm, pn; };
struct Gemm { const bf16_t* A; const bf16_t* Bt; int M, N, K, lda, ldb; };

struct StaticOrder {
    int nM, nN, nwg, G, c, wgm;
    __host__ __device__ void init(int M, int N, int G_, int c_, int wgm_ = WGM) { nM = M / BM; nN = N / BM; nwg = nM * nN; G = G_; c = c_; wgm = wgm_; }
    __host__ __device__ bool next(int i, Unit& u) const {
        const int L = i * G + c; if (L >= nwg) return false;
        int wgid = L; { const int q = nwg / NXCD, r = nwg % NXCD, xcd = wgid % NXCD, off = wgid / NXCD; wgid = (xcd < r ? xcd * (q + 1) : r * (q + 1) + (xcd - r) * q) + off; }
        const int nig = wgm * nN, gid = wgid / nig, fm = gid * wgm, gsz = (nM - fm) < wgm ? (nM - fm) : wgm;
        u.pm = fm + ((wgid % nig) % gsz); u.pn = (wgid % nig) / gsz; return true;
    }
    __device__ __forceinline__ void a_ready(const Unit&) const {}
    __device__ __forceinline__ void done(const Unit&) const {}
};
__device__ __forceinline__ unsigned cvt_pk_bf16(float lo, float hi) { unsigned r; asm volatile("v_cvt_pk_bf16_f32 %0, %1, %2" : "=v"(r) : "v"(lo), "v"(hi)); return r; }
typedef float f32x2 __attribute__((ext_vector_type(2)));
typedef unsigned u32x2 __attribute__((ext_vector_type(2)));
__device__ __forceinline__ float fast_silu(float v) { return v * __builtin_amdgcn_rcpf(1.0f + __builtin_amdgcn_exp2f(-1.4426950408889634f * v)); }
__device__ __forceinline__ float bf_lo(unsigned u) { return __uint_as_float(u << 16); }
__device__ __forceinline__ float bf_hi(unsigned u) { return __uint_as_float(u & 0xffff0000u); }

struct EpiZ {
    static constexpr bool PERM = true, AFTER_DRAIN = false;
    bf16_t* O; int ldc; const float* bias; int nvalid; float* ssq;
    __device__ __forceinline__ void operator()(const f32x4 (&acc)[2][2][4][2], const Unit& u, int wr, int wc, int fr, int fq) const {
        asm volatile("" : "+v"(fr), "+v"(fq), "+s"(wr), "+s"(wc));
        const int row0 = u.pm * BM + wr * 64 + fr; const int col0 = u.pn * BM + wc * 32 + 8 * fq;
        f32x4 bv[2][2];
#pragma unroll
        for (int bj = 0; bj < 2; ++bj)
#pragma unroll
            for (int n = 0; n < 2; ++n) bv[bj][n] = *(const f32x4*)(bias + col0 + bj * HALF + 4 * n);
        if (u.pn < 3) {
#pragma unroll
            for (int ai = 0; ai < 2; ++ai)
#pragma unroll
                for (int m = 0; m < 4; ++m) { float s = 0.f;
#pragma unroll
                    for (int bj = 0; bj < 2; ++bj)
#pragma unroll
                        for (int n = 0; n < 2; ++n) { const f32x4 x = acc[ai][bj][m][n] + bv[bj][n]; s += (x[0] * x[0] + x[1] * x[1]) + (x[2] * x[2] + x[3] * x[3]); }
                    s += xshfl<16>(s); s = xsum32(s);
                    if (fq == 0) ssq[(size_t)(row0 + ai * HALF + m * 16) * 12 + u.pn * 4 + wc] = s; }
        }
#pragma unroll
        for (int ai = 0; ai < 2; ++ai)
#pragma unroll
            for (int m = 0; m < 4; ++m) { bf16_t* rowp = O + (size_t)(row0 + ai * HALF + m * 16) * ldc + col0;
#pragma unroll
                for (int bj = 0; bj < 2; ++bj) { const f32x4 v0 = acc[ai][bj][m][0] + bv[bj][0], v1 = acc[ai][bj][m][1] + bv[bj][1];
                    u32x4 w; w.x = cvt_pk_bf16(v0[0], v0[1]); w.y = cvt_pk_bf16(v0[2], v0[3]); w.z = cvt_pk_bf16(v1[0], v1[1]); w.w = cvt_pk_bf16(v1[2], v1[3]);
                    if (col0 + bj * HALF < nvalid) __builtin_nontemporal_store(w, (u32x4*)(rowp + bj * HALF)); } }
    }
};
struct EpiV {
    static constexpr bool PERM = false, AFTER_DRAIN = false;
    bf16_t* O; const float* ssq;
    __device__ __forceinline__ void operator()(const f32x4 (&acc)[2][2][4][2], const Unit& u, int wr, int wc, int fr, int fq) const {
        asm volatile("" : "+v"(fr), "+v"(fq), "+s"(wr), "+s"(wc));
        const int t0 = u.pm * BM, b = t0 / SEQ, s0 = t0 % SEQ;
        float rk8[2][4];
#pragma unroll
        for (int ai = 0; ai < 2; ++ai)
#pragma unroll
            for (int m = 0; m < 4; ++m) { const f32x4 sl = *(const f32x4*)(ssq + (size_t)(t0 + ai * HALF + wr * 64 + m * 16 + fr) * 12 + 8);
                rk8[ai][m] = __builtin_amdgcn_rsqf(((sl[0] + sl[1]) + (sl[2] + sl[3])) * (1.0f / 256.0f) + 1e-6f); }
#pragma unroll
        for (int ai = 0; ai < 2; ++ai)
#pragma unroll
            for (int m = 0; m < 4; ++m) { const int r = ai * HALF + wr * 64 + m * 16 + fr;
                const float rk = rk8[ai][m];
#pragma unroll
                for (int bj = 0; bj < 2; ++bj) { bf16_t* dst = O + ((size_t)((b * NH + 2 * u.pn + bj) * SEQ + s0 + r)) * VD + wc * 32 + 4 * fq;
#pragma unroll
                    for (int n = 0; n < 2; ++n) { const f32x4 v = acc[ai][bj][m][n] * rk; u32x2 w; w.x = cvt_pk_bf16(v[0], v[1]); w.y = cvt_pk_bf16(v[2], v[3]); *(u32x2*)(dst + 16 * n) = w; } } }
    }
};
struct EpiPw {
    static constexpr bool PERM = true, AFTER_DRAIN = false;
    bf16_t* mix; const bf16_t* z; const float* bpw;
    __device__ __forceinline__ void operator()(const f32x4 (&acc)[2][2][4][2], const Unit& u, int wr, int wc, int fr, int fq) const {
        asm volatile("" : "+v"(fr), "+v"(fq), "+s"(wr), "+s"(wc));
        const int col0 = u.pn * BM + wc * 32 + 8 * fq;
        f32x4 bv[2][2];
#pragma unroll
        for (int bj = 0; bj < 2; ++bj)
#pragma unroll
            for (int n = 0; n < 2; ++n) bv[bj][n] = *(const f32x4*)(bpw + col0 + bj * HALF + 4 * n);
#pragma unroll
        for (int ai = 0; ai < 2; ++ai)
#pragma unroll
            for (int m = 0; m < 4; ++m) { const size_t t = (size_t)(u.pm * BM + ai * HALF + wr * 64 + m * 16 + fr);
#pragma unroll
                for (int bj = 0; bj < 2; ++bj) { const int c = col0 + bj * HALF; const u32x4 gz = *(const u32x4*)(z + t * INC + Z_CG + c);
                    const f32x4 v0 = acc[ai][bj][m][0] + bv[bj][0], v1 = acc[ai][bj][m][1] + bv[bj][1];
                    u32x4 w; w.x = cvt_pk_bf16(v0[0] * fast_silu(bf_lo(gz.x)), v0[1] * fast_silu(bf_hi(gz.x))); w.y = cvt_pk_bf16(v0[2] * fast_silu(bf_lo(gz.y)), v0[3] * fast_silu(bf_hi(gz.y)));
                    w.z = cvt_pk_bf16(v1[0] * fast_silu(bf_lo(gz.z)), v1[1] * fast_silu(bf_hi(gz.z))); w.w = cvt_pk_bf16(v1[2] * fast_silu(bf_lo(gz.w)), v1[3] * fast_silu(bf_hi(gz.w)));
                    *(u32x4*)(mix + t * DM + DC + c) = w; }
                if (m & 1) asm volatile("" ::: "memory"); }
    }
};
struct EpiOut {
    static constexpr bool PERM = true, AFTER_DRAIN = false;
    const float* xin; float* xout; const float* gate;
    __device__ __forceinline__ void operator()(const f32x4 (&acc)[2][2][4][2], const Unit& u, int wr, int wc, int fr, int fq) const {
        asm volatile("" : "+v"(fr), "+v"(fq), "+s"(wr), "+s"(wc));
        const int col0 = u.pn * BM + wc * 32 + 8 * fq; const int b = (u.pm * BM) / SEQ;
        f32x4 gv[2][2];
#pragma unroll
        for (int bj = 0; bj < 2; ++bj)
#pragma unroll
            for (int n = 0; n < 2; ++n) gv[bj][n] = *(const f32x4*)(gate + (size_t)b * 6144 + col0 + bj * HALF + 4 * n);
#pragma unroll
        for (int ai = 0; ai < 2; ++ai)
#pragma unroll
            for (int m = 0; m < 4; ++m) { const size_t off = (size_t)(u.pm * BM + ai * HALF + wr * 64 + m * 16 + fr) * DM + col0;
#pragma unroll
                for (int bj = 0; bj < 2; ++bj)
#pragma unroll
                    for (int n = 0; n < 2; ++n) { const f32x4 xv = *(const f32x4*)(xin + off + bj * HALF + 4 * n);
                        *(f32x4*)(xout + off + bj * HALF + 4 * n) = xv + gv[bj][n] * acc[ai][bj][m][n]; }
                if (m == 3) asm volatile("" ::: "memory"); }
    }
};
struct EpiHead {
    static constexpr bool PERM = true, AFTER_DRAIN = false;
    bf16_t* O; const float* g; const float* cs; const float* sn; PG8_LAS float* P; const float* ssq; int qmode;
    __device__ __forceinline__ void operator()(const f32x4 (&acc)[2][2][4][2], const Unit& u, int wr, int wc, int fr, int fq) const {
        asm volatile("" : "+v"(fr), "+v"(fq), "+s"(wr), "+s"(wc));
        float rl8[2][4];
#pragma unroll
        for (int ai = 0; ai < 2; ++ai)
#pragma unroll
            for (int m = 0; m < 4; ++m) { const float* sp = ssq + (size_t)(u.pm * BM + ai * HALF + wr * 64 + m * 16 + fr) * 12; float lat;
                if (qmode) { const f32x4 a4 = *(const f32x4*)sp, b4 = *(const f32x4*)(sp + 4); lat = (((a4[0] + a4[1]) + (a4[2] + a4[3])) + ((b4[0] + b4[1]) + (b4[2] + b4[3]))) * (1.0f / 512.0f); }
                else { const f32x4 a4 = *(const f32x4*)(sp + 8); lat = ((a4[0] + a4[1]) + (a4[2] + a4[3])) * (1.0f / 256.0f); }
                rl8[ai][m] = __builtin_amdgcn_rsqf(lat + 1e-6f); }
#pragma unroll
        for (int ai = 0; ai < 2; ++ai)
#pragma unroll
            for (int m = 0; m < 4; ++m) { float s0 = 0.f, s1 = 0.f;
#pragma unroll
                for (int n = 0; n < 2; ++n) { const f32x4 x = acc[ai][0][m][n], y = acc[ai][1][m][n];
                    s0 += (x[0] * x[0] + x[1] * x[1]) + (x[2] * x[2] + x[3] * x[3]); s1 += (y[0] * y[0] + y[1] * y[1]) + (y[2] * y[2] + y[3] * y[3]); }
                s0 += xshfl<16>(s0); s0 = xsum32(s0); s1 += xshfl<16>(s1); s1 = xsum32(s1);
                if (fq == 0) { PG8_LAS float* pp = P + ((ai * HALF + wr * 64 + m * 16 + fr) * 4 + wc) * 2; pp[0] = s0; pp[1] = s1; } }
        asm volatile("s_waitcnt lgkmcnt(0)" ::: "memory"); __builtin_amdgcn_s_barrier(); asm volatile("" ::: "memory");
        const int t0 = u.pm * BM, b = t0 / SEQ, s0r = t0 % SEQ, h = u.pn, e = 16 * wc + 4 * fq;
        f32x4 g0[2], g1 = {0.f, 0.f, 0.f, 0.f}, g2 = {0.f, 0.f, 0.f, 0.f};
#pragma unroll
        for (int n = 0; n < 2; ++n) g0[n] = *(const f32x4*)(g + wc * 32 + 8 * fq + 4 * n);
        if (wc < 2) { g1 = *(const f32x4*)(g + 128 + e); g2 = *(const f32x4*)(g + 160 + e); }
#pragma unroll
        for (int ai = 0; ai < 2; ++ai)
#pragma unroll
            for (int m = 0; m < 4; ++m) { const int r = ai * HALF + wr * 64 + m * 16 + fr;
                const f32x4 pa = *(const PG8_LAS f32x4*)(P + r * 8), pb = *(const PG8_LAS f32x4*)(P + r * 8 + 4);
                const float S0 = (pa[0] + pa[2]) + (pb[0] + pb[2]), S1 = (pa[1] + pa[3]) + (pb[1] + pb[3]);
                const float rl = rl8[ai][m], rr = qmode ? rl : 1.0f;
                const float f = __builtin_amdgcn_rsqf((rl * rl * S0 + rr * rr * S1) * (1.0f / 192.0f) + 1e-6f), fn = rl * f, fp = rr * f;
                bf16_t* dst = O + ((size_t)((b * NH + h) * SEQ + s0r + r)) * QKD;
                { const f32x4 v0 = acc[ai][0][m][0] * fn * g0[0], v1 = acc[ai][0][m][1] * fn * g0[1]; u32x4 w; w.x = cvt_pk_bf16(v0[0], v0[1]); w.y = cvt_pk_bf16(v0[2], v0[3]); w.z = cvt_pk_bf16(v1[0], v1[1]); w.w = cvt_pk_bf16(v1[2], v1[3]); *(u32x4*)(dst + wc * 32 + 8 * fq) = w; }
                if (wc < 2) { const size_t tt = (size_t)(t0 + r) * 32 + e; const f32x4 c4 = *(const f32x4*)(cs + tt), s4 = *(const f32x4*)(sn + tt);
                    const f32x4 x1 = acc[ai][1][m][0] * fp * g1, x2 = acc[ai][1][m][1] * fp * g2; const f32x4 o1 = x1 * c4 - x2 * s4, o2 = x2 * c4 + x1 * s4;
                    u32x2 w1, w2; w1.x = cvt_pk_bf16(o1[0], o1[1]); w1.y = cvt_pk_bf16(o1[2], o1[3]); w2.x = cvt_pk_bf16(o2[0], o2[1]); w2.y = cvt_pk_bf16(o2[2], o2[3]);
                    *(u32x2*)(dst + 128 + e) = w1; *(u32x2*)(dst + 160 + e) = w2; }
                if (m & 1) asm volatile("" ::: "memory"); }
    }
};
template <class Epi, class Sched, bool ALIGN_EPI = false, bool SP2 = false>
__device__ __forceinline__ void gemm_phase(PG8_LAS unsigned char* lds, const Gemm g, const Sched& S, const Epi& E) {
    int tid_ = threadIdx.x; asm volatile("" : "+v"(tid_));
    const int tid = tid_, wid = __builtin_amdgcn_readfirstlane(tid >> 6), lane = tid & 63, wr = wid >> 2, wc = wid & 3, fr = lane & 15, fq = lane >> 4;
    const int K = g.K, nt = K / BK;
    unsigned voffA[2], voffB[2];
#pragma unroll
    for (int i = 0; i < 2; ++i) { int R, C; stage_rc(tid * 16 + i * 8192, R, C); const int Rb = Epi::PERM ? ((R & ~31) + perm32(R & 31)) : R;
        voffA[i] = (unsigned)(R * g.lda + C) * 2u; voffB[i] = (unsigned)(Rb * g.ldb + C) * 2u; }
    const size_t kstep = (size_t)(BK * 2);
    const size_t hstepA = (size_t)HALF * g.lda * 2, hstepB = (size_t)HALF * g.ldb * 2;
    const size_t tstepA = 2 * hstepA, tstepB = 2 * hstepB;
    const unsigned ldsw = (unsigned)wid * 1024u;
    const int aoff = lds_byte(wr * 64 + fr, fq * 8), boff = lds_byte(wc * 32 + fr, fq * 8);
#define PG8_SA(b, h) (((b) * 2 + (h)) * HTB)
#define PG8_SB(b, h) ((4 + (b) * 2 + (h)) * HTB)
#define PG8_STAGE(bufoff, gbase, voff) do { _Pragma("unroll") for (int _i = 0; _i < 2; ++_i) \
        __builtin_amdgcn_global_load_lds((const unsigned*)((const char*)(gbase) + (voff)[_i]), (PG8_LAS unsigned*)(lds + (bufoff) + ldsw + _i * 8192), 16, 0, 0); } while (0)
#define PG8_LDA(dst, b, h) do { _Pragma("unroll") for (int m = 0; m < 4; ++m) _Pragma("unroll") for (int k = 0; k < 2; ++k) dst[m][k] = *(const PG8_LAS bf16x8*)(lds + PG8_SA(b, h) + aoff + m * 2048 + k * 1024); } while (0)
#define PG8_LDB(dst, b, h) do { _Pragma("unroll") for (int n = 0; n < 2; ++n) _Pragma("unroll") for (int k = 0; k < 2; ++k) dst[n][k] = *(const PG8_LAS bf16x8*)(lds + PG8_SB(b, h) + boff + n * 2048 + k * 1024); } while (0)
#define PG8_MMA(ai, bj, At, Bt) do { __builtin_amdgcn_s_setprio(1); _Pragma("unroll") for (int m = 0; m < 4; ++m) _Pragma("unroll") for (int n = 0; n < 2; ++n) _Pragma("unroll") for (int k = 0; k < 2; ++k) \
        acc[ai][bj][m][n] = __builtin_amdgcn_mfma_f32_16x16x32_bf16(Bt[n][k], At[m][k], acc[ai][bj][m][n], 0, 0, 0); __builtin_amdgcn_s_setprio(0); } while (0)
#define PG8_WAIT_V(n) asm volatile("s_waitcnt vmcnt(" #n ")" ::: "memory")
#define PG8_WAIT_L(n) asm volatile("s_waitcnt lgkmcnt(" #n ")" ::: "memory")
#define PG8_BAR __builtin_amdgcn_s_barrier()
#define PG8_SCHED __builtin_amdgcn_sched_barrier(0)
    Unit cur, nxt; int ui = 0;
    if (!S.next(0, cur)) return;
    f32x4 acc[2][2][4][2];
#pragma unroll
    for (int a = 0; a < 2; ++a)
#pragma unroll
        for (int b = 0; b < 2; ++b)
#pragma unroll
            for (int m = 0; m < 4; ++m)
#pragma unroll
                for (int n = 0; n < 2; ++n) acc[a][b][m][n] = (f32x4){0.f, 0.f, 0.f, 0.f};
    bf16x8 At[4][2], B0[2][2], B1[2][2];
    const char* cA = (const char*)g.A + (size_t)cur.pm * tstepA; const char* cB = (const char*)g.Bt + (size_t)cur.pn * tstepB;
    S.a_ready(cur);
    if constexpr (SP2) {
        PG8_STAGE(PG8_SB(0, 0), cB, voffB); PG8_STAGE(PG8_SB(0, 1), cB + hstepB, voffB); PG8_STAGE(PG8_SA(0, 0), cA, voffA); PG8_STAGE(PG8_SA(0, 1), cA + hstepA, voffA);
        if (wr == 1) PG8_BAR;
        PG8_WAIT_V(2); PG8_BAR;
        PG8_STAGE(PG8_SB(1, 0), cB + kstep, voffB); PG8_STAGE(PG8_SA(1, 0), cA + kstep, voffA); PG8_STAGE(PG8_SB(1, 1), cB + hstepB + kstep, voffB);
        PG8_WAIT_V(6); PG8_BAR;
    } else {
        PG8_STAGE(PG8_SB(0, 0), cB, voffB); PG8_STAGE(PG8_SA(0, 0), cA, voffA); PG8_STAGE(PG8_SB(0, 1), cB + hstepB, voffB); PG8_STAGE(PG8_SA(0, 1), cA + hstepA, voffA);
        if (wr == 1) PG8_BAR;
        PG8_WAIT_V(4); PG8_BAR;
        PG8_STAGE(PG8_SB(1, 0), cB + kstep, voffB); PG8_STAGE(PG8_SA(1, 0), cA + kstep, voffA); PG8_STAGE(PG8_SB(1, 1), cB + hstepB + kstep, voffB);
        PG8_WAIT_V(6); PG8_BAR;
    }
    for (;;) {
        const bool has_next = S.next(ui + 1, nxt);
        const char* nA = has_next ? (const char*)g.A + (size_t)nxt.pm * tstepA : cA; const char* nB = has_next ? (const char*)g.Bt + (size_t)nxt.pn * tstepB : cB;
        for (int t = 0; t < nt; t += 2) {
            const bool last = (t == nt - 2);
            const char* a1 = cA + (size_t)(t + 1) * kstep;
            const char* a2 = last ? nA : cA + (size_t)(t + 2) * kstep; const char* b2 = last ? nB : cB + (size_t)(t + 2) * kstep;
            const char* a3 = a2 + kstep; const char* b3 = b2 + kstep;
            if (last && has_next) S.a_ready(nxt);
            if constexpr (SP2) {
            PG8_LDB(B0, 0, 0); PG8_LDB(B1, 0, 1); PG8_SCHED; PG8_LDA(At, 0, 0); PG8_STAGE(PG8_SA(1, 1), a1 + hstepA, voffA);
            PG8_WAIT_V(8); PG8_WAIT_L(0); PG8_BAR; PG8_MMA(0, 0, At, B0); PG8_MMA(0, 1, At, B1); PG8_BAR; PG8_SCHED;
            PG8_LDA(At, 0, 1); PG8_STAGE(PG8_SB(0, 0), b2, voffB); PG8_STAGE(PG8_SB(0, 1), b2 + hstepB, voffB); PG8_STAGE(PG8_SA(0, 0), a2, voffA);
            PG8_WAIT_V(8); PG8_WAIT_L(0); PG8_BAR; PG8_MMA(1, 0, At, B0); PG8_MMA(1, 1, At, B1); PG8_BAR; PG8_SCHED;
            PG8_LDB(B0, 1, 0); PG8_LDB(B1, 1, 1); PG8_SCHED; PG8_LDA(At, 1, 0); PG8_STAGE(PG8_SA(0, 1), a2 + hstepA, voffA);
            PG8_WAIT_V(8); PG8_WAIT_L(0); PG8_BAR; PG8_MMA(0, 0, At, B0); PG8_MMA(0, 1, At, B1); PG8_BAR; PG8_SCHED;
            PG8_LDA(At, 1, 1); PG8_STAGE(PG8_SB(1, 0), b3, voffB); PG8_STAGE(PG8_SB(1, 1), b3 + hstepB, voffB); PG8_STAGE(PG8_SA(1, 0), a3, voffA);
            PG8_WAIT_V(8); PG8_WAIT_L(0); PG8_BAR; PG8_MMA(1, 0, At, B0); PG8_MMA(1, 1, At, B1); PG8_BAR; PG8_SCHED;
            } else {
            PG8_LDB(B0, 0, 0); PG8_SCHED; PG8_LDA(At, 0, 0); PG8_STAGE(PG8_SA(1, 1), a1 + hstepA, voffA);
            PG8_WAIT_L(8); PG8_BAR; PG8_WAIT_L(0); PG8_MMA(0, 0, At, B0); PG8_BAR; PG8_SCHED;
            PG8_LDB(B1, 0, 1); PG8_STAGE(PG8_SB(0, 0), b2, voffB);
            PG8_BAR; PG8_WAIT_L(0); PG8_MMA(0, 1, At, B1); PG8_BAR;
            PG8_LDA(At, 0, 1); PG8_STAGE(PG8_SA(0, 0), a2, voffA);
            PG8_BAR; PG8_WAIT_L(0); PG8_MMA(1, 0, At, B0); PG8_BAR; PG8_SCHED;
            PG8_STAGE(PG8_SB(0, 1), b2 + hstepB, voffB);
            PG8_WAIT_V(6); PG8_BAR; PG8_MMA(1, 1, At, B1); PG8_BAR;
            PG8_LDB(B0, 1, 0); PG8_SCHED; PG8_LDA(At, 1, 0); PG8_STAGE(PG8_SA(0, 1), a2 + hstepA, voffA);
            PG8_WAIT_L(8); PG8_BAR; PG8_WAIT_L(0); PG8_MMA(0, 0, At, B0); PG8_BAR; PG8_SCHED;
            PG8_LDB(B1, 1, 1); PG8_STAGE(PG8_SB(1, 0), b3, voffB);
            PG8_BAR; PG8_WAIT_L(0); PG8_MMA(0, 1, At, B1); PG8_BAR;
            PG8_LDA(At, 1, 1); PG8_STAGE(PG8_SA(1, 0), a3, voffA);
            PG8_BAR; PG8_WAIT_L(0); PG8_MMA(1, 0, At, B0); PG8_BAR; PG8_SCHED;
            PG8_STAGE(PG8_SB(1, 1), b3 + hstepB, voffB);
            PG8_WAIT_V(6); PG8_BAR; PG8_MMA(1, 1, At, B1); PG8_BAR;
            }
        }
        if constexpr (ALIGN_EPI) { if (wr == 0) PG8_BAR; }
        if constexpr (!Epi::AFTER_DRAIN) { int t2_ = threadIdx.x; asm volatile("" : "+v"(t2_)); E(acc, cur, wr, wc, t2_ & 15, (t2_ & 63) >> 4); S.done(cur); }
        if (!has_next) break;
#pragma unroll
        for (int a = 0; a < 2; ++a)
#pragma unroll
            for (int b = 0; b < 2; ++b)
#pragma unroll
                for (int m = 0; m < 4; ++m)
#pragma unroll
                    for (int n = 0; n < 2; ++n) acc[a][b][m][n] = (f32x4){0.f, 0.f, 0.f, 0.f};
        cur = nxt; cA = nA; cB = nB; ++ui;
        if constexpr (ALIGN_EPI) { if (wr == 1) PG8_BAR; }
    }
    PG8_WAIT_V(0);
    if constexpr (!ALIGN_EPI) { if (wr == 0) PG8_BAR; }
    PG8_BAR;
    if constexpr (Epi::AFTER_DRAIN) { E.fused(acc, cur, wr, wc, fr, fq, lds, wid, lane); S.done(cur); }
#undef PG8_SA
#undef PG8_SB
#undef PG8_STAGE
#undef PG8_LDA
#undef PG8_LDB
#undef PG8_MMA
#undef PG8_WAIT_V
#undef PG8_WAIT_L
#undef PG8_BAR
#undef PG8_SCHED
}
}
namespace att {
#define ALAS __attribute__((address_space(3)))
typedef unsigned short bf16_t;
typedef short bf16x8 __attribute__((ext_vector_type(8)));
typedef short s16x4 __attribute__((ext_vector_type(4)));
typedef float f32x16 __attribute__((ext_vector_type(16)));
typedef float f32x4 __attribute__((ext_vector_type(4)));
typedef unsigned u32x4 __attribute__((ext_vector_type(4)));
constexpr int NW = 8, QBLK = 32, KVBLK = 64, QB = 256;
constexpr int KROW = 400;
constexpr int SHM_V = KVBLK * VD * 2, SHM_K = KVBLK * KROW;
constexpr int LDS_V = 0, LDS_K = 2 * SHM_V, LDS_WS = LDS_K + 2 * SHM_K, LDS_BYTES = LDS_WS + NW * 64 * 4;
constexpr float SCALE = 0.07216878364870323f;
constexpr float THR = 8.f;
#define SBAR() __builtin_amdgcn_sched_barrier(0)
__device__ __forceinline__ int v_st(int k, int c) { const int kk = (k & ~0xC) | ((k & 4) << 1) | ((k & 8) >> 1); return ((kk >> 3) * 4 + (c >> 5)) * 512 + ((kk & 7) * 32 + (c & 31)) * 2; }
__device__ __forceinline__ int v_rd_base(int lane) { return ((lane & 3) << 3) | (((lane >> 2) & 3) << 6) | (((lane >> 4) & 1) << 5) | (((lane >> 5) & 1) << 8); }
constexpr int v_rd_off(int d0, int ks, int half) { return d0 * 512 + ks * 4096 + half * 2048; }
__device__ __forceinline__ int crow(int r, int hi) { return (r & 3) + 8 * (r >> 2) + 4 * hi; }
__device__ __forceinline__ unsigned cvtpk(float lo, float hi) { unsigned r; asm volatile("v_cvt_pk_bf16_f32 %0, %1, %2" : "=v"(r) : "v"(lo), "v"(hi)); return r; }
__device__ __forceinline__ void mask_tile(f32x16& p0, f32x16& p1, int dq) {
    const float NEG = -__builtin_inff();
#pragma unroll
    for (int r = 0; r < 16; ++r) { const int c = (r & 3) + 8 * (r >> 2); if (dq - c < 0) p0[r] = NEG; if (dq - c - 32 < 0) p1[r] = NEG; }
}
__device__ __forceinline__ void partialSM(f32x16& p0, f32x16& p1, float& m_reg, float& mn, float& alpha) {
    float pmax = p0[0];
#pragma unroll
    for (int r = 1; r < 16; ++r) pmax = fmaxf(pmax, p0[r]);
#pragma unroll
    for (int r = 0; r < 16; ++r) pmax = fmaxf(pmax, p1[r]);
    { auto rr = __builtin_amdgcn_permlane32_swap(__float_as_uint(pmax), __float_as_uint(pmax), false, false); pmax = fmaxf(__uint_as_float(rr[0]), __uint_as_float(rr[1])); }
    constexpr float C2 = 1.4426950408889634f * SCALE;
    if (__builtin_expect(__all((pmax - m_reg) * SCALE <= THR), 1)) { mn = m_reg; alpha = 1.f; }
    else { mn = fmaxf(m_reg, pmax); alpha = __builtin_amdgcn_exp2f((m_reg - mn) * C2); m_reg = mn; }
    const float mnL = -mn * C2;
#pragma unroll
    for (int r = 0; r < 16; ++r) p0[r] = fmaf(p0[r], C2, mnL);
#pragma unroll
    for (int r = 0; r < 16; ++r) p1[r] = fmaf(p1[r], C2, mnL);
#pragma unroll
    for (int r = 0; r < 16; ++r) p0[r] = __builtin_amdgcn_exp2f(p0[r]);
}
__device__ __forceinline__ void finishSM(f32x16& p0, f32x16& p1, float alpha, float& l_reg, bf16x8& pa0, bf16x8& pa1, bf16x8& pa2, bf16x8& pa3) {
#pragma unroll
    for (int r = 0; r < 16; ++r) p1[r] = __builtin_amdgcn_exp2f(p1[r]);
    float ps = 0;
#pragma unroll
    for (int r = 0; r < 16; ++r) ps += p0[r];
#pragma unroll
    for (int r = 0; r < 16; ++r) ps += p1[r];
    { auto rr = __builtin_amdgcn_permlane32_swap(__float_as_uint(ps), __float_as_uint(ps), false, false); ps = __uint_as_float(rr[0]) + __uint_as_float(rr[1]); }
    l_reg = l_reg * alpha + ps;
#define PK4(P, B_, OUT) do { unsigned a0 = cvtpk(P[B_+0], P[B_+1]), a1 = cvtpk(P[B_+2], P[B_+3]);                          \
        unsigned b0 = cvtpk(P[B_+4], P[B_+5]), b1 = cvtpk(P[B_+6], P[B_+7]);                                             \
        auto r0 = __builtin_amdgcn_permlane32_swap(a0, b0, false, false); auto r1 = __builtin_amdgcn_permlane32_swap(a1, b1, false, false); \
        u32x4 w = {r0[0], r1[0], r0[1], r1[1]}; OUT = *reinterpret_cast<bf16x8*>(&w); } while (0)
    PK4(p0, 0, pa0); PK4(p0, 8, pa1); PK4(p1, 0, pa2); PK4(p1, 8, pa3);
#undef PK4
}
#ifndef QK_DEPTH
#define QK_DEPTH 6
#endif
template <int KB>
__device__ __forceinline__ void qkt(f32x16& p0, f32x16& p1, const ALAS char* kb, const bf16x8* qr) {
    p0 = f32x16{}; p1 = f32x16{};
#define KRD(f) (*(const ALAS bf16x8*)(kb + KB * SHM_K + ((f) >> 1) * 32 + ((f) & 1) * 32 * KROW))
    bf16x8 kf[QK_DEPTH];
#pragma unroll
    for (int f = 0; f < QK_DEPTH; ++f) kf[f] = KRD(f);
    SBAR();
#pragma unroll
    for (int f = 0; f < 24; ++f) {
        if (f & 1) p1 = __builtin_amdgcn_mfma_f32_32x32x16_bf16(kf[f % QK_DEPTH], qr[f >> 1], p1, 0, 0, 0);
        else       p0 = __builtin_amdgcn_mfma_f32_32x32x16_bf16(kf[f % QK_DEPTH], qr[f >> 1], p0, 0, 0, 0);
        if (f + QK_DEPTH < 24) kf[f % QK_DEPTH] = KRD(f + QK_DEPTH);
        SBAR();
    }
#undef KRD
}
template <int VB>
__device__ __forceinline__ void pv_tile(f32x16* o, int vb0, bf16x8 pa0, bf16x8 pa1, bf16x8 pa2, bf16x8 pa3) {
#define TRRD(dst, off) asm volatile("ds_read_b64_tr_b16 %0, %1 offset:%2" : "=&v"(dst) : "v"(vb0), "i"(off) : "memory")
#define PV_D0(d0) do { s16x4 l0, l1, l2, l3, h0, h1, h2, h3; constexpr int b_ = VB * SHM_V + v_rd_off(d0, 0, 0); \
        TRRD(l0, b_); TRRD(h0, b_ + 2048); TRRD(l1, b_ + 4096); TRRD(h1, b_ + 6144); TRRD(l2, b_ + 8192); TRRD(h2, b_ + 10240); TRRD(l3, b_ + 12288); TRRD(h3, b_ + 14336); \
        asm volatile("s_waitcnt lgkmcnt(0)" ::: "memory"); SBAR(); \
        o[d0] = __builtin_amdgcn_mfma_f32_32x32x16_bf16(pa0, (bf16x8){l0[0], l0[1], l0[2], l0[3], h0[0], h0[1], h0[2], h0[3]}, o[d0], 0, 0, 0);   \
        o[d0] = __builtin_amdgcn_mfma_f32_32x32x16_bf16(pa1, (bf16x8){l1[0], l1[1], l1[2], l1[3], h1[0], h1[1], h1[2], h1[3]}, o[d0], 0, 0, 0);   \
        o[d0] = __builtin_amdgcn_mfma_f32_32x32x16_bf16(pa2, (bf16x8){l2[0], l2[1], l2[2], l2[3], h2[0], h2[1], h2[2], h2[3]}, o[d0], 0, 0, 0);   \
        o[d0] = __builtin_amdgcn_mfma_f32_32x32x16_bf16(pa3, (bf16x8){l3[0], l3[1], l3[2], l3[3], h3[0], h3[1], h3[2], h3[3]}, o[d0], 0, 0, 0); } while (0)
    PV_D0(0); PV_D0(1); PV_D0(2); PV_D0(3);
#undef PV_D0
#undef TRRD
}
__device__ __forceinline__ float silu_f(float v) { return v * __builtin_amdgcn_rcpf(1.0f + __builtin_amdgcn_exp2f(-1.4426950408889634f * v)); }

__device__ __forceinline__ void attn_block(const bf16_t* __restrict__ Qh, const bf16_t* __restrict__ Kh, const bf16_t* __restrict__ Vh, int qb,
                                           bf16_t* __restrict__ mixp, const bf16_t* __restrict__ zg, ALAS char* lds) {
    int tid_ = threadIdx.x; asm volatile("" : "+v"(tid_));
    const int tid = tid_, wid = __builtin_amdgcn_readfirstlane(tid >> 6), lane = tid & 63, r32 = lane & 31, hi = lane >> 5;
    const int NT = 4 * (qb + 1);
    const int qlo = qb * QB + wid * QBLK, qm = qlo + r32 - 4 * hi;
    ALAS char* V_lds = lds + LDS_V; ALAS char* K_lds = lds + LDS_K;
    ALAS float* ws = (ALAS float*)(lds + LDS_WS) + wid * 64; ALAS float* li_l = ws; ALAS float* al_l = ws + 32;
    float m_reg = -1e30f, l_reg = 0; f32x16 o[4] = {};
    const int sr = tid >> 4, sc = (tid & 15) * 8, vst0 = v_st(sr, sc), vst1 = v_st(32 + sr, sc);
    int kld[3];
#pragma unroll
    for (int i = 0; i < 3; ++i) { const int ci = tid + 512 * i; kld[i] = (ci / 24) * KROW + (ci % 24) * 16; }
    const int vb0 = (int)(unsigned)(uintptr_t)V_lds + v_rd_base(lane);
    const ALAS char* kb = K_lds + r32 * KROW + hi * 16;
    bf16x8 qr[12];
#pragma unroll
    for (int d0 = 0; d0 < 12; ++d0) qr[d0] = *(const bf16x8*)((const char*)Qh + (unsigned)(((qlo + r32) * QKD + d0 * 16 + hi * 8) * 2));
    bf16x8 st_v0, st_v1, st_k0, st_k1, st_k2;
    const unsigned vof0 = (unsigned)((sr * VD + sc) * 2), vof1 = vof0 + 32 * VD * 2, kof0 = (unsigned)tid * 16u, kof1 = kof0 + 8192u, kof2 = kof0 + 16384u;
#define SLOAD(t) do { const char* vt_ = (const char*)Vh + (size_t)(t) * (KVBLK * VD * 2); const char* kt_ = (const char*)Kh + (size_t)(t) * (KVBLK * QKD * 2); \
        st_v0 = *(const bf16x8*)(vt_ + vof0); st_v1 = *(const bf16x8*)(vt_ + vof1); st_k0 = *(const bf16x8*)(kt_ + kof0); st_k1 = *(const bf16x8*)(kt_ + kof1); st_k2 = *(const bf16x8*)(kt_ + kof2); } while (0)
#define SWRITE(bf) do { *(ALAS bf16x8*)(V_lds + (bf) * SHM_V + vst0) = st_v0; *(ALAS bf16x8*)(V_lds + (bf) * SHM_V + vst1) = st_v1; \
        *(ALAS bf16x8*)(K_lds + (bf) * SHM_K + kld[0]) = st_k0; *(ALAS bf16x8*)(K_lds + (bf) * SHM_K + kld[1]) = st_k1; *(ALAS bf16x8*)(K_lds + (bf) * SHM_K + kld[2]) = st_k2; } while (0)
#define RESC(a) do { if (__any((a) < 1.f)) { if (hi == 0) al_l[r32] = (a); asm volatile("s_waitcnt lgkmcnt(0)" ::: "memory");              \
                     _Pragma("unroll") for (int d_ = 0; d_ < 4; ++d_) _Pragma("unroll") for (int r = 0; r < 16; ++r) o[d_][r] *= al_l[crow(r, hi)]; } } while (0)
#define MASKT(P0_, P1_, t) do { const int kb_ = (t) * KVBLK; if (kb_ + KVBLK - 1 > qlo) mask_tile(P0_, P1_, qm - kb_); } while (0)
    f32x16 p0, p1; float mn, al; bf16x8 pa0, pa1, pa2, pa3;
    SLOAD(0); SWRITE(0); SLOAD(1);
    __syncthreads();
#define STEP(t, KB) do { if ((t) + 1 < NT) { SWRITE(1 - KB); } if ((t) + 2 < NT) { SLOAD((t) + 2); } SBAR();            \
        qkt<KB>(p0, p1, kb, qr); MASKT(p0, p1, (t)); partialSM(p0, p1, m_reg, mn, al); RESC(al);                       \
        finishSM(p0, p1, al, l_reg, pa0, pa1, pa2, pa3); SBAR(); pv_tile<KB>(o, vb0, pa0, pa1, pa2, pa3);               \
        __syncthreads(); } while (0)
    for (int t = 0; t < NT; t += 2) { STEP(t, 0); STEP(t + 1, 1); }
#undef STEP
    if (hi == 0) li_l[r32] = l_reg; asm volatile("s_waitcnt lgkmcnt(0)" ::: "memory");
    { int le = lane; asm volatile("" : "+v"(le));
      const int r32e = le & 31, hie = le >> 5;
      ALAS char* stg = lds + wid * 8192;
#pragma unroll
      for (int r = 0; r < 16; ++r) { const int orow = crow(r, hie); const float rl = __builtin_amdgcn_rcpf(li_l[orow]);
#pragma unroll
          for (int d0 = 0; d0 < 4; ++d0) { const float v = o[d0][r] * rl; const float vn = xshfl<1>(v);
              if ((r32e & 1) == 0) *(ALAS unsigned*)(stg + orow * 256 + (d0 * 32 + r32e) * 2) = cvtpk(v, vn); } }
      asm volatile("s_waitcnt lgkmcnt(0)" ::: "memory");
#pragma unroll
      for (int i = 0; i < 8; ++i) { const int c = le + 64 * i, row = c >> 4, ch = c & 15;
          const u32x4 ov = *(const ALAS u32x4*)(stg + row * 256 + ch * 16);
          const u32x4 gz = *(const u32x4*)((const char*)zg + (unsigned)(((qlo + row) * INC + ch * 8) * 2));
#define GM(O_, G_) cvtpk(__uint_as_float((O_) << 16) * silu_f(__uint_as_float((G_) << 16)), __uint_as_float((O_) & 0xffff0000u) * silu_f(__uint_as_float((G_) & 0xffff0000u)))
          u32x4 w; w.x = GM(ov.x, gz.x); w.y = GM(ov.y, gz.y); w.z = GM(ov.z, gz.z); w.w = GM(ov.w, gz.w);
#undef GM
          *(u32x4*)((char*)mixp + (unsigned)(((qlo + row) * DM + ch * 8) * 2)) = w; } }
    __syncthreads();
#undef SLOAD
#undef SWRITE
#undef RESC
#undef MASKT
}
#undef SBAR
}
#define LAS __attribute__((address_space(3)))
#define CAS __attribute__((address_space(4)))
typedef unsigned short bf16_t;
typedef float f32x4 __attribute__((ext_vector_type(4)));
typedef float f32x2 __attribute__((ext_vector_type(2)));
typedef unsigned u32x4 __attribute__((ext_vector_type(4)));
typedef unsigned u32x2 __attribute__((ext_vector_type(2)));
using pg8::cvt_pk_bf16; using pg8::bf_lo; using pg8::bf_hi; using pg8::fast_silu;

constexpr int NWAVES = 8, NTHREADS = 512;
constexpr int RING_BYTES = 131072, EXCH_OFF = RING_BYTES, BST_OFF = EXCH_OFF + 8192, LDS_BYTES = BST_OFF + 64;
constexpr int PH_PER_LAYER = 5, N_PHASES = 1 + PH_PER_LAYER * DEPTH;
#ifndef EN_P0
#define EN_P0 1
#endif
#ifndef EN_A
#define EN_A 1
#endif
#ifndef EN_B
#define EN_B 1
#endif
#ifndef EN_C1
#define EN_C1 1
#endif
#ifndef EN_C2
#define EN_C2 1
#endif
#ifndef EN_D
#define EN_D 1
#endif
#ifndef EN_E
#define EN_E 1
#endif
#ifndef EN_ATT
#define EN_ATT 1
#endif
#ifndef EN_PW
#define EN_PW 1
#endif
#ifndef REP_P0
#define REP_P0 1
#endif
#ifndef REP_A
#define REP_A 1
#endif
#ifndef REP_B
#define REP_B 1
#endif
#ifndef REP_C1
#define REP_C1 1
#endif
#ifndef REP_C2
#define REP_C2 1
#endif
#ifndef REP_ATT
#define REP_ATT 1
#endif
#ifndef REP_PW
#define REP_PW 1
#endif
#ifndef REP_E0
#define REP_E0 1
#endif
#ifndef REP_LAT
#define REP_LAT 1
#endif
#ifndef REP_CONV
#define REP_CONV 1
#endif
#ifndef REP_GEMV
#define REP_GEMV 1
#endif
#ifndef REP_CVT
#define REP_CVT 1
#endif
#ifndef WGM_B
#define WGM_B 5
#endif
#ifndef WGM_E
#define WGM_E 2
#endif
#ifndef WGM_QK
#define WGM_QK 8
#endif
#ifndef WGM_V
#define WGM_V 4
#endif
#ifndef WGM_PW
#define WGM_PW 4
#endif
#ifndef MK_ONE_LAUNCH
#define MK_ONE_LAUNCH 1
#endif

constexpr size_t MiB = 1u << 20;
constexpr size_t WS_MOD = 1 * MiB;
constexpr size_t WS_BIAS = WS_MOD + 256 * 1024;
constexpr size_t WS_COS = 2 * MiB, WS_SIN = 4 * MiB;
constexpr size_t WS_WIN = 6 * MiB;
constexpr size_t WS_WQ = 46 * MiB;
constexpr size_t WS_WK = 50 * MiB;
constexpr size_t WS_WV = 53 * MiB;
constexpr size_t WS_WPW = 54 * MiB;
constexpr size_t WS_WOUT = 58 * MiB;
constexpr size_t WS_H = 74 * MiB;
constexpr size_t WS_Z = 138 * MiB;
constexpr size_t WS_SSQ = 292 * MiB;
constexpr size_t WS_Q = 320 * MiB, WS_K = 368 * MiB;
constexpr size_t WS_V = 416 * MiB;
constexpr size_t WS_U2 = 448 * MiB;
constexpr size_t WS_END = 480 * MiB;

__device__ __forceinline__ float fast_sigmoid(float v) { return __builtin_amdgcn_rcpf(1.0f + __builtin_amdgcn_exp2f(-1.4426950408889634f * v)); }

#define XB_TMO      128
#define XB_XCNT(j)  (256  + 64 * (j))
#define XB_XSUB(j)  (1280 + 64 * (j))
#define XB_XGEN(j)  (2304 + 64 * (j))
#define XB_TOP      3328
#define XB_TOPGEN   3392
#define XCD_BAR_WORDS 3456
#define XB_SPIN_CAP (1u << 18)

__device__ __forceinline__ unsigned xb_ld(unsigned* p)              { return __hip_atomic_load(p, __ATOMIC_RELAXED, __HIP_MEMORY_SCOPE_AGENT); }
__device__ __forceinline__ unsigned xb_add(unsigned* p, unsigned v) { return __hip_atomic_fetch_add(p, v, __ATOMIC_RELAXED, __HIP_MEMORY_SCOPE_AGENT); }
__device__ __forceinline__ unsigned xb_xcc_id() { return (unsigned)__builtin_amdgcn_s_getreg((3 << 11) | 20) & 0xFu; }
#define XB_SPIN(cond, bar) do { unsigned _sp = 0; while (cond) { __builtin_amdgcn_s_sleep(1); \
    if ((++_sp & 255u) == 0u) { if (xb_ld(&(bar)[XB_TMO])) break; if (_sp > XB_SPIN_CAP) { atomicAdd(&(bar)[XB_TMO], 1u); break; } } } } while (0)

struct XcdBarrier {
    unsigned* bar; unsigned x;
    volatile LAS unsigned* st;
};

__device__ __forceinline__ XcdBarrier xcd_barrier_post(unsigned* bar, volatile LAS unsigned* st) {
    XcdBarrier b; b.bar = bar; b.x = xb_xcc_id(); b.st = st;
    if (threadIdx.x == 0) (void)xb_add(&bar[XB_XCNT(b.x)], 1u);
    return b;
}
__device__ __forceinline__ void xcd_barrier_complete(unsigned* bar, unsigned x, unsigned& nloc, unsigned& nx) {
    const unsigned G = gridDim.x * gridDim.y * gridDim.z;
    unsigned sum, cnt, mine, sp = 0u;
    for (;;) {
        sum = 0u; cnt = 0u; mine = 0u;
#pragma unroll
        for (unsigned j = 0; j < 16; ++j) { const unsigned c = xb_ld(&bar[XB_XCNT(j)]); sum += c; cnt += (c > 0u) ? 1u : 0u; mine = (j == x) ? c : mine; }
        if (sum == G) break;
        __builtin_amdgcn_s_sleep(1);
        if ((++sp & 255u) == 0u) { if (xb_ld(&bar[XB_TMO])) break; if (sp > XB_SPIN_CAP) { atomicAdd(&bar[XB_TMO], 1u); break; } }
    }
    nloc = mine > 0u ? mine : 1u; nx = cnt > 0u ? cnt : 1u;
}

__device__ __forceinline__ void xcd_barrier(const XcdBarrier& b) {
    asm volatile("s_waitcnt vmcnt(0)" ::: "memory");
    __syncthreads();
    if (threadIdx.x == 0) {
        unsigned* bar = b.bar;
        __builtin_amdgcn_s_waitcnt(0);
        unsigned nloc = b.st[0], nx = b.st[1];
        if (nloc == 0u) { xcd_barrier_complete(bar, b.x, nloc, nx); b.st[0] = nloc; b.st[1] = nx; }
        const unsigned old = xb_add(&bar[XB_XSUB(b.x)], 1u);
        const unsigned gen = old / nloc;
        if (old + 1u == (gen + 1u) * nloc) {
            __builtin_amdgcn_fence(__ATOMIC_RELEASE, "agent");
            asm volatile("s_waitcnt vmcnt(0)" ::: "memory");
            const unsigned og = xb_add(&bar[XB_TOP], 1u);
            const unsigned tg = og / nx;
            if (og + 1u == (tg + 1u) * nx) xb_add(&bar[XB_TOPGEN], 1u);
            else XB_SPIN(xb_ld(&bar[XB_TOPGEN]) == tg, bar);
            __builtin_amdgcn_fence(__ATOMIC_ACQUIRE, "agent");
            xb_add(&bar[XB_XGEN(b.x)], 1u);
            asm volatile("s_waitcnt vmcnt(0)" ::: "memory");
        } else {
            XB_SPIN(xb_ld(&bar[XB_XGEN(b.x)]) == gen, bar);
            __builtin_amdgcn_fence(__ATOMIC_ACQUIRE, "agent");
            asm volatile("s_waitcnt vmcnt(0)" ::: "memory");
        }
    }
    __syncthreads();
}

__device__ __forceinline__ int hmap(int c) {
    if (c < 128) return c;
    if (c >= 192) return -1;
    const int q = c - 128, wc = q >> 5, fq = (q >> 3) & 3, n = (q >> 2) & 1, j = q & 3;
    return 128 + 32 * n + 16 * wc + 4 * fq + j;
}
__device__ __forceinline__ void cvt_load(float (&v)[32], const float* __restrict__ W, const float* __restrict__ gk, int Nsrc, int Ksrc, int col, int idk, int k0, int lane) {
#pragma unroll
    for (int i = 0; i < 32; ++i) { const int k = k0 + 2 * i + (lane >> 5); float x = 0.f;
        if (col >= 0 && k < Ksrc) { x = __builtin_nontemporal_load(W + (size_t)k * Nsrc + col); if (gk) x *= gk[k]; }
        if (k == idk) x = 1.f;
        v[i] = x; }
}
__device__ __forceinline__ void cvt_store(const float (&v)[32], bf16_t* __restrict__ WT, int Kout, int n0, int k0, LAS float* scr, int lane) {
#pragma unroll
    for (int i = 0; i < 32; ++i) scr[(2 * i + (lane >> 5)) * 33 + (lane & 31)] = v[i];
    asm volatile("s_waitcnt lgkmcnt(0)" ::: "memory");
    const int c = lane & 7;
#pragma unroll
    for (int j = 0; j < 4; ++j) { const int n = (lane >> 3) + 8 * j; const LAS float* s = scr + (8 * c) * 33 + n;
        u32x4 o; o.x = cvt_pk_bf16(s[0 * 33], s[1 * 33]); o.y = cvt_pk_bf16(s[2 * 33], s[3 * 33]); o.z = cvt_pk_bf16(s[4 * 33], s[5 * 33]); o.w = cvt_pk_bf16(s[6 * 33], s[7 * 33]);
        *(u32x4*)(WT + (size_t)(n0 + n) * Kout + k0 + 8 * c) = o; }
    asm volatile("s_waitcnt lgkmcnt(0)" ::: "memory");
}
struct CvtDst { bf16_t* WT; int Kout, n0, k0; };

template <int SI> __device__ __forceinline__ void conv_step(f32x2 (&av)[32], const f32x2 (&wv)[CK], const f32x2 u) {
#pragma unroll
    for (int tt = 0; tt < 32; ++tt) { const int j = SI - tt; if (j >= 0 && j <= 30) av[tt] = wv[j] * u + av[tt]; }
}

struct Args { const float* in[21]; float* out; unsigned char* ws; int ph_lo, ph_hi; };

__global__ void __launch_bounds__(NTHREADS, 2) mk_fwd(Args a) {
    extern __shared__ __attribute__((aligned(16))) unsigned char lds_raw[];
    LAS unsigned char* lds = (LAS unsigned char*)lds_raw;
    cg::grid_group grid = cg::this_grid();
    const int lo = a.ph_lo, hi = a.ph_hi;
    volatile LAS unsigned* bst = (volatile LAS unsigned*)(lds + BST_OFF);
    if (threadIdx.x < 2) bst[threadIdx.x] = 0u;
    __syncthreads();
    XcdBarrier xbar; xbar.bar = (unsigned*)a.ws; xbar.x = 0; xbar.st = bst;
    if (hi - lo > 1) xbar = xcd_barrier_post((unsigned*)a.ws, bst);
#define PHASE_BEGIN() \
    const CAS Args* ap = (const CAS Args*)__builtin_amdgcn_kernarg_segment_ptr(); asm volatile("" : "+s"(ap)); \
    int tid = threadIdx.x; asm volatile("" : "+v"(tid)); \
    const int lane = tid & 63, wave = __builtin_amdgcn_readfirstlane(tid >> 6); \
    int G = gridDim.x, bx = blockIdx.x; asm volatile("" : "+s"(G), "+s"(bx)); \
    const int gw = bx * NWAVES + wave, NGW = G * NWAVES; \
    unsigned char* ws = ap->ws; (void)lane; (void)gw; (void)NGW; (void)ws;
#define INP(i) (ap->in[i])
#define IN(k) (lo <= (k) && (k) < hi)
#ifndef USE_CG_SYNC
#define USE_CG_SYNC 0
#endif
#define SEAM(k) do { if (IN(k) && IN((k) + 1)) { if (USE_CG_SYNC || (k) == 0) grid.sync(); else xcd_barrier(xbar); } } while (0)

    for (int rep_ = 0; rep_ < REP_P0; ++rep_) if (EN_P0 && IN(0)) {
        PHASE_BEGIN();
        const float* c_in = INP(1); const int* positions = (const int*)INP(2); const float* ada_w = INP(3); const float* ada_b = INP(4); const float* w_in = INP(6);
        const float* w_q_up = INP(8); const float* w_kv_up = INP(10); const float* q_lat_g = INP(7); const float* kv_lat_g = INP(9); const float* glu_b = INP(13); const float* w_pw = INP(18); const float* w_out = INP(20);
        float* modb = (float*)(ws + WS_MOD); float* biasb = (float*)(ws + WS_BIAS); float* cosb = (float*)(ws + WS_COS); float* sinb = (float*)(ws + WS_SIN);
        bf16_t* Win_t = (bf16_t*)(ws + WS_WIN); bf16_t* Wq_t = (bf16_t*)(ws + WS_WQ); bf16_t* Wk_t = (bf16_t*)(ws + WS_WK); bf16_t* Wv_t = (bf16_t*)(ws + WS_WV);
        bf16_t* Wpw_t = (bf16_t*)(ws + WS_WPW); bf16_t* Wout_t = (bf16_t*)(ws + WS_WOUT);
        LAS float* scl = (LAS float*)lds;
        LAS float* red = (LAS float*)(lds + 32768);
        { for (int i = tid; i < NB * DM; i += NTHREADS) { const int b = i / DM, k = i % DM; scl[k * 4 + b] = fast_silu(c_in[i]); } __syncthreads(); }
        for (int rg_ = 0; rg_ < REP_GEMV; ++rg_) for (int task = bx; task < 256; task += G) {
            const int l = task >> 7, col = (task & 127) * 48 + (lane < 48 ? lane : 47);
            const float* wp = ada_w + (size_t)l * DM * 6144 + (size_t)(wave * 256) * 6144 + col;
            float a0 = 0.f, a1 = 0.f, a2 = 0.f, a3 = 0.f;
#pragma unroll 64
            for (int k = 0; k < 256; ++k) { const float wv = __builtin_nontemporal_load(wp + (size_t)k * 6144); const f32x4 s = *(const LAS f32x4*)(scl + (wave * 256 + k) * 4);
                a0 += s[0] * wv; a1 += s[1] * wv; a2 += s[2] * wv; a3 += s[3] * wv; }
            red[(wave * 4 + 0) * 64 + lane] = a0; red[(wave * 4 + 1) * 64 + lane] = a1; red[(wave * 4 + 2) * 64 + lane] = a2; red[(wave * 4 + 3) * 64 + lane] = a3;
            __syncthreads();
            if (tid < 256) { const int b = tid >> 6; float s = 0.f;
#pragma unroll
                for (int w = 0; w < 8; ++w) s += red[(w * 4 + b) * 64 + lane];
                if (lane < 48) modb[(size_t)(l * NB + b) * 6144 + col] = s + ada_b[l * 6144 + col]; }
            __syncthreads();
        }
        for (int i = bx * NTHREADS + tid; i < T * 32; i += G * NTHREADS) { const int t = i >> 5, j = i & 31;
            const float inv = 1.0f / powf(10000.0f, (float)(2 * j) * (1.0f / 64.0f)); const float ang = (float)positions[t] * inv;
            cosb[i] = cosf(ang); sinb[i] = sinf(ang); }
        for (int i = bx * NTHREADS + tid; i < DEPTH * INCP; i += G * NTHREADS) { const int l = i / INCP, c = i % INCP;
            biasb[i] = (c >= Z_CV && c < Z_CG) ? glu_b[l * 2048 + (c - Z_CV)] : 0.f; }
        {
            LAS float* scr = (LAS float*)(lds + 40960 + wave * 8448);
            constexpr int I0 = 5120, I1 = I0 + 512, I2 = I1 + 384, I3 = I2 + 128, I4 = I3 + 512, I5 = I4 + 2048;
            float va[32], vb[32]; CvtDst da, db;
#define CVT_ISSUE(IT, V, D) { const int it = (IT); \
                const int l = it / I5; int r = it % I5; \
                const float* W; int Nsrc, Ksrc, Kout, nN; bf16_t* WT; int mat; \
                if (r < I0) { mat = 0; W = w_in + (size_t)l * DM * INC; Nsrc = INC; Ksrc = DM; Kout = DM; nN = INCP / 32; WT = Win_t + (size_t)l * INCP * DM; } \
                else if (r < I1) { r -= I0; mat = 1; W = w_q_up + (size_t)l * QL * 1536; Nsrc = 1536; Ksrc = QL; Kout = KQ; nN = 64; WT = Wq_t + (size_t)l * 2048 * KQ; } \
                else if (r < I2) { r -= I1; mat = 2; W = w_kv_up + (size_t)l * KVL * 2048; Nsrc = 2048; Ksrc = KVL; Kout = KK; nN = 64; WT = Wk_t + (size_t)l * 2048 * KK; } \
                else if (r < I3) { r -= I2; mat = 3; W = w_kv_up + (size_t)l * KVL * 2048; Nsrc = 2048; Ksrc = KVL; Kout = KV; nN = 32; WT = Wv_t + (size_t)l * 1024 * KV; } \
                else if (r < I4) { r -= I3; mat = 4; W = w_pw + (size_t)l * DC * DC; Nsrc = DC; Ksrc = DC; Kout = DC; nN = 32; WT = Wpw_t + (size_t)l * DC * DC; } \
                else { r -= I4; mat = 5; W = w_out + (size_t)l * DM * DM; Nsrc = DM; Ksrc = DM; Kout = DM; nN = 64; WT = Wout_t + (size_t)l * DM * DM; } \
                const int kb = r / nN, nb = r % nN, n0 = nb * 32, k0 = kb * 64, n = n0 + (lane & 31); \
                int col = n, idk = -1; \
                if (mat == 0) col = n < INC ? n : -1; \
                else if (mat == 1) { const int hc = hmap(n & 255); col = hc >= 0 ? (n >> 8) * QKD + hc : -1; } \
                else if (mat == 2) { const int hc = hmap(n & 255); if (hc < 0) col = -1; else if (hc < 128) col = (n >> 8) * 256 + hc; else { col = -1; idk = 256 + (hc - 128); } } \
                else if (mat == 3) col = (n >> 7) * 256 + 128 + (n & 127); \
                const float* gk = (mat == 1) ? q_lat_g + l * QL : (mat == 2 || mat == 3) ? kv_lat_g + l * KVL : nullptr; \
                D.WT = WT; D.Kout = Kout; D.n0 = n0; D.k0 = k0; cvt_load(V, W, gk, Nsrc, Ksrc, col, idk, k0, lane); }
            for (int rv_ = 0; rv_ < REP_CVT; ++rv_) {
                int it0 = gw;
                if (it0 < DEPTH * I5) CVT_ISSUE(it0, va, da)
                for (; it0 < DEPTH * I5; it0 += 2 * NGW) {
                    const bool hb = it0 + NGW < DEPTH * I5, ha = it0 + 2 * NGW < DEPTH * I5;
                    if (hb) CVT_ISSUE(it0 + NGW, vb, db)
                    cvt_store(va, da.WT, da.Kout, da.n0, da.k0, scr, lane);
                    if (ha) CVT_ISSUE(it0 + 2 * NGW, va, da)
                    if (hb) cvt_store(vb, db.WT, db.Kout, db.n0, db.k0, scr, lane);
                }
            }
#undef CVT_ISSUE
        }
    }
    SEAM(0);

#pragma unroll 1
    for (int l = 0; l < DEPTH; ++l) {
        const int pb = 1 + PH_PER_LAYER * l;
        for (int rep_ = 0; rep_ < REP_A; ++rep_) if (EN_A && IN(pb)) {
            PHASE_BEGIN();
            const float* xin = (l == 0) ? INP(0) : (const float*)ap->out; const float* mod_l = (const float*)(ws + WS_MOD) + (size_t)l * NB * 6144;
            bf16_t* Hb = (bf16_t*)(ws + WS_H);
            const float* g = INP(5) + l * DM;
            for (int row0 = gw * 8; row0 < T; row0 += NGW * 8) {
                const int b = row0 / SEQ;
                f32x4 gs[8], sh[8];
#pragma unroll
                for (int j = 0; j < 8; ++j) { const int col = 4 * lane + 256 * j; const f32x4 g4 = *(const f32x4*)(g + col), s4 = *(const f32x4*)(mod_l + b * 6144 + 2048 + col);
                    gs[j] = g4 * (1.0f + s4); sh[j] = *(const f32x4*)(mod_l + b * 6144 + col); }
#pragma unroll 2
                for (int r = 0; r < 8; ++r) { const float* xr = xin + (size_t)(row0 + r) * DM + 4 * lane; f32x4 v[8]; float ss = 0.f;
#pragma unroll
                    for (int j = 0; j < 8; ++j) { v[j] = __builtin_nontemporal_load((const f32x4*)(xr + 256 * j)); ss +=     (v[j][0] * v[j][0] + v[j][1] * v[j][1]) + (v[j][2] * v[j][2] + v[j][3] * v[j][3]); }
                    const float rinv = __builtin_amdgcn_rsqf(wave_sum(ss) * (1.0f / DM) + EPS);
                    bf16_t* hr = Hb + (size_t)(row0 + r) * DM + 4 * lane;
#pragma unroll
                    for (int j = 0; j < 8; ++j) { const f32x4 o = v[j] * rinv * gs[j] + sh[j]; u32x2 w; w.x = cvt_pk_bf16(o[0], o[1]); w.y = cvt_pk_bf16(o[2], o[3]); *(u32x2*)(hr + 256 * j) = w; } }
            }
        }
        SEAM(pb);
        for (int rep_ = 0; rep_ < REP_B; ++rep_) if (EN_B && IN(pb + 1)) {
            PHASE_BEGIN();
            bf16_t* Hb = (bf16_t*)(ws + WS_H); bf16_t* Zb = (bf16_t*)(ws + WS_Z); bf16_t* Win_t = (bf16_t*)(ws + WS_WIN); float* biasb = (float*)(ws + WS_BIAS);
            pg8::Gemm g{Hb, Win_t + (size_t)l * INCP * DM, T, INCP, DM, DM, DM}; pg8::StaticOrder S; { int bxo = bx; asm volatile("" : "+s"(bxo)); S.init(T, INCP, G, bxo, WGM_B); }
            pg8::EpiZ E{Zb, INC, biasb + l * INCP, INC, (float*)(ws + WS_SSQ)};
            pg8::gemm_phase<pg8::EpiZ, pg8::StaticOrder, true, true>(lds, g, S, E);
        }
        SEAM(pb + 1);
        for (int rep_ = 0; rep_ < REP_C2; ++rep_) if (EN_C2 && IN(pb + 2)) {
            PHASE_BEGIN();
            bf16_t* Zb = (bf16_t*)(ws + WS_Z); bf16_t* U2 = (bf16_t*)(ws + WS_U2); const float* ssq = (const float*)(ws + WS_SSQ);
            const float* dw_w = INP(14); const float* dw_b = INP(15); const float* conv_ln_g = INP(16); const float* conv_ln_b = INP(17);
            bf16_t* Qb = (bf16_t*)(ws + WS_Q); bf16_t* Kb = (bf16_t*)(ws + WS_K); bf16_t* Vb = (bf16_t*)(ws + WS_V);
            bf16_t* Wq_t = (bf16_t*)(ws + WS_WQ); bf16_t* Wk_t = (bf16_t*)(ws + WS_WK); bf16_t* Wv_t = (bf16_t*)(ws + WS_WV); float* cosb = (float*)(ws + WS_COS); float* sinb = (float*)(ws + WS_SIN);
            const float* q_norm_g = INP(11); const float* k_norm_g = INP(12);
            LAS float* P = (LAS float*)(lds + EXCH_OFF);
            { pg8::Gemm g{Zb, Wq_t + (size_t)l * 2048 * KQ, T, 2048, KQ, INC, KQ}; pg8::StaticOrder S; { int bxo = bx; asm volatile("" : "+s"(bxo)); S.init(T, 2048, G, bxo, WGM_QK); }
              pg8::EpiHead E{Qb, q_norm_g + l * QKD, cosb, sinb, P, ssq, 1};
              pg8::gemm_phase<pg8::EpiHead, pg8::StaticOrder, true, true>(lds, g, S, E); }
            { pg8::Gemm g{Zb + Z_KVL, Wk_t + (size_t)l * 2048 * KK, T, 2048, KK, INC, KK};     pg8::StaticOrder S; { int bxo = bx; asm volatile("" : "+s"(bxo)); S.init(T, 2048, G, bxo, WGM_QK); }
              pg8::EpiHead E{Kb, k_norm_g + l * QKD, cosb, sinb, P, ssq, 0};
              pg8::gemm_phase<pg8::EpiHead, pg8::StaticOrder, true, true>(lds, g, S, E); }
            { pg8::Gemm g{Zb + Z_KVL, Wv_t + (size_t)l * 1024 * KV, T, 1024, KV, INC, KV}; pg8::StaticOrder S; { int bxo = bx; asm volatile("" : "+s"(bxo)); S.init(T, 1024, G, bxo, WGM_V); }
              pg8::EpiV E{Vb, ssq};
              pg8::gemm_phase<pg8::EpiV, pg8::StaticOrder, true, true>(lds, g, S, E); }
            {
                LAS bf16_t* ubuf = (LAS bf16_t*)lds;
                LAS float* red = (LAS float*)(lds + 126976);
                const int c0 = 2 * tid;
                const float* dww = dw_w + (size_t)l * CK * DC;
                const int vcu_c = (G % 8 == 0) ? (bx % 8) * (G / 8) + bx / 8 : bx, ipb_c = (T / 32 + G - 1) / G;
                for (int rc_ = 0; rc_ < REP_CONV; ++rc_) for (int item = vcu_c * ipb_c; item < T / 32 && item < (vcu_c + 1) * ipb_c; ++item) {
                    const int t0 = item * 32, s0 = t0 % SEQ;
#pragma unroll 8
                    for (int itc = 0; itc < 16; ++itc) { const int ck = tid + NTHREADS * itc; if (ck < 62 * 128) { const int si = ck >> 7, c8 = (ck & 127) * 8; u32x4 o = {0u, 0u, 0u, 0u};
                        if (s0 - 30 + si >= 0) { const bf16_t* zr = Zb + (size_t)(t0 - 30 + si) * INC; const u32x4 vv = *(const u32x4*)(zr + Z_CV + c8), gg = *(const u32x4*)(zr + Z_CGL + c8);
                            o.x = cvt_pk_bf16(bf_lo(vv.x) * fast_sigmoid(bf_lo(gg.x)), bf_hi(vv.x) * fast_sigmoid(bf_hi(gg.x))); o.y = cvt_pk_bf16(bf_lo(vv.y) * fast_sigmoid(bf_lo(gg.y)), bf_hi(vv.y) * fast_sigmoid(bf_hi(gg.y)));
                            o.z = cvt_pk_bf16(bf_lo(vv.z) * fast_sigmoid(bf_lo(gg.z)), bf_hi(vv.z) * fast_sigmoid(bf_hi(gg.z))); o.w = cvt_pk_bf16(bf_lo(vv.w) * fast_sigmoid(bf_lo(gg.w)), bf_hi(vv.w) * fast_sigmoid(bf_hi(gg.w))); }
                        *(LAS u32x4*)(ubuf + si * DC + c8) = o; } }
                    __syncthreads();
                    f32x2 wv[CK];
#pragma unroll
                    for (int j = 0; j < CK; ++j) wv[j] = *(const f32x2*)(dww + j * DC + c0);
                    f32x2 av[32];
                    { const f32x2 bb = *(const f32x2*)(dw_b + l * DC + c0);
#pragma unroll
                      for (int tt = 0; tt < 32; ++tt) av[tt] = bb; }
#define CS(SI) { const unsigned uu = *(const LAS unsigned*)(ubuf + (SI) * DC + c0); conv_step<SI>(av, wv, (f32x2){bf_lo(uu), bf_hi(uu)}); }
                    CS(0) CS(1) CS(2) CS(3) CS(4) CS(5) CS(6) CS(7) CS(8) CS(9) CS(10) CS(11) CS(12) CS(13) CS(14) CS(15) CS(16) CS(17) CS(18) CS(19) CS(20) CS(21) CS(22) CS(23) CS(24) CS(25) CS(26) CS(27) CS(28) CS(29) CS(30) CS(31) CS(32) CS(33) CS(34) CS(35) CS(36) CS(37) CS(38) CS(39) CS(40) CS(41) CS(42) CS(43) CS(44) CS(45) CS(46) CS(47) CS(48) CS(49) CS(50) CS(51) CS(52) CS(53) CS(54) CS(55) CS(56) CS(57) CS(58) CS(59) CS(60) CS(61)
#undef CS
                    float v[64];
#pragma unroll
                    for (int tt = 0; tt < 32; ++tt) { v[tt] = av[tt][0] + av[tt][1]; v[32 + tt] = av[tt][0] * av[tt][0] + av[tt][1] * av[tt][1]; }
                    { const bool up = (lane & 32) != 0;
#pragma unroll
                      for (int i = 0; i < 32; ++i) { const float send = up ? v[i] : v[i + 32]; const float keep = up ? v[i + 32] : v[i]; v[i] = keep + xswap32(send, up); } }
#define TRED(STEP) { const bool up = (lane & STEP) != 0; _Pragma("unroll") for (int i = 0; i < STEP; ++i) { const float send = up ? v[i] : v[i + STEP]; const float keep = up ? v[i + STEP] : v[i]; v[i] = keep + xshfl<STEP>(send); } }
                    TRED(16) TRED(8) TRED(4) TRED(2) TRED(1)
#undef TRED
                    red[wave * 64 + lane] = v[0];
                    __syncthreads();
                    float tot = 0.f;
#pragma unroll
                    for (int w = 0; w < 8; ++w) tot += red[w * 64 + lane];
                    const float other = xswap32(tot, lane >= 32);
                    const float s1 = lane < 32 ? tot : other, s2 = lane < 32 ? other : tot;
                    const float mean = s1 * (1.0f / DC), var = s2 * (1.0f / DC) - mean * mean, rstd = __builtin_amdgcn_rsqf(var + EPS);
                    const f32x2 lg = *(const f32x2*)(conv_ln_g + l * DC + c0), lb = *(const f32x2*)(conv_ln_b + l * DC + c0);
#pragma unroll
                    for (int tt = 0; tt < 32; ++tt) { const float m = __int_as_float(__builtin_amdgcn_readlane(__float_as_int(mean), tt)), rs = __int_as_float(__builtin_amdgcn_readlane(__float_as_int(rstd), tt));
                        const float o0 = (av[tt][0] - m) * rs * lg[0] + lb[0], o1 = (av[tt][1] - m) * rs * lg[1] + lb[1];
                        *(unsigned*)(U2 + (size_t)(t0 + tt) * DC + c0) = cvt_pk_bf16(fast_silu(o0), fast_silu(o1)); }
                    __syncthreads();
                }
            }
        }
        SEAM(pb + 2);
        if (EN_D && IN(pb + 3)) {
            PHASE_BEGIN();
            bf16_t* Hb = (bf16_t*)(ws + WS_H); bf16_t* Zb = (bf16_t*)(ws + WS_Z); bf16_t* Qb = (bf16_t*)(ws + WS_Q); bf16_t* Kb = (bf16_t*)(ws + WS_K); bf16_t* Vb = (bf16_t*)(ws + WS_V);
            bf16_t* U2 = (bf16_t*)(ws + WS_U2); bf16_t* Wpw_t = (bf16_t*)(ws + WS_WPW); const float* b_pw = INP(19);
            const int vcu = (G % 8 == 0) ? (bx % 8) * (G / 8) + bx / 8 : bx;
            for (int rep_ = 0; rep_ < REP_ATT; ++rep_) for (int it = vcu; it < NB * NH * 8; it += G) {
                const int bh = it >> 3, xq = it & 7, b = bh / NH, h = bh % NH;
                const bf16_t* Qh = Qb + (size_t)bh * SEQ * QKD; const bf16_t* Kh = Kb + (size_t)bh * SEQ * QKD; const bf16_t* Vh = Vb + (size_t)bh * SEQ * VD;
                bf16_t* mixp = Hb + (size_t)b * SEQ * DM + h * VD; const bf16_t* zg = Zb + (size_t)b * SEQ * INC + Z_MG + h * VD;
#pragma unroll 1
                for (int pass = 0; pass < 2 * EN_ATT; ++pass) att::attn_block(Qh, Kh, Vh, pass ? xq : 15 - xq, mixp, zg, (LAS char*)lds);
            }
            for (int rep_ = 0; rep_ < REP_PW; ++rep_) if (EN_PW) { pg8::Gemm g{U2, Wpw_t + (size_t)l * DC * DC, T, DC, DC, DC, DC}; pg8::StaticOrder S; { int bxo = bx; asm volatile("" : "+s"(bxo)); S.init(T, DC, G, bxo, WGM_PW); }
              pg8::EpiPw E{Hb, Zb, b_pw + l * DC};
              pg8::gemm_phase<pg8::EpiPw, pg8::StaticOrder, true, true>(lds, g, S, E); }
        }
        SEAM(pb + 3);
        for (int rep_ = 0; rep_ < (l == 0 ? REP_E0 : 1); ++rep_) if (EN_E && IN(pb + 4)) {
            PHASE_BEGIN();
            bf16_t* Hb = (bf16_t*)(ws + WS_H); bf16_t* Wout_t = (bf16_t*)(ws + WS_WOUT);
            const float* xin = (l == 0) ? INP(0) : (const float*)ap->out; const float* mod_l = (const float*)(ws + WS_MOD) + (size_t)l * NB * 6144;
            pg8::Gemm g{Hb, Wout_t + (size_t)l * DM * DM, T, DM, DM, DM, DM}; pg8::StaticOrder S; { int bxo = bx; asm volatile("" : "+s"(bxo)); S.init(T, DM, G, bxo, WGM_E); }
            pg8::EpiOut E{xin, ap->out, mod_l + 4096};
            pg8::gemm_phase<pg8::EpiOut, pg8::StaticOrder, true, true>(lds, g, S, E);
        }
        SEAM(pb + 4);
    }
#undef IN
#undef SEAM
}

extern "C" void kernel_launch(void* const* d_in, const int* in_sizes, int n_in, void* d_out, int out_size, void* d_ws, size_t ws_size, hipStream_t stream) {
    static int grid = 0;
    if (grid == 0) {
        if (n_in != 21 || in_sizes[0] != T * DM || out_size != T * DM || ws_size < WS_END) { fprintf(stderr, "kernel_launch: unexpected shapes (n_in %d, in0 %d, out %d, ws %zu)\n", n_in, n_in > 0 ? in_sizes[0] : -1, out_size, ws_size); grid = -1; return; }
        int dev = 0, cus = 0, per_cu = 0;
        (void)hipGetDevice(&dev); (void)hipDeviceGetAttribute(&cus, hipDeviceAttributeMultiprocessorCount, dev);
        if (hipFuncSetAttribute((const void*)mk_fwd, hipFuncAttributeMaxDynamicSharedMemorySize, LDS_BYTES) != hipSuccess) { fprintf(stderr, "kernel_launch: hipFuncSetAttribute failed\n"); grid = -1; return; }
        if (hipOccupancyMaxActiveBlocksPerMultiprocessor(&per_cu, (const void*)mk_fwd, NTHREADS, LDS_BYTES) != hipSuccess || per_cu < 1) { fprintf(stderr, "kernel_launch: occupancy query says %d blocks per CU\n", per_cu); per_cu = 1; }
        (void)hipGetLastError();
        grid = cus * 1;
        fprintf(stderr, "kernel_launch: %d CUs, occupancy %d, grid %d\n", cus, per_cu, grid);
    }
    if (grid < 0) return;
    Args a{};
    for (int i = 0; i < 21; ++i) a.in[i] = (const float*)d_in[i];
    a.out = (float*)d_out; a.ws = (unsigned char*)d_ws;
#if MK_ONE_LAUNCH
    (void)hipMemsetAsync(d_ws, 0, 16384, stream);
    a.ph_lo = 0; a.ph_hi = N_PHASES;
    void* args[] = {&a};
    hipError_t e = hipLaunchCooperativeKernel((const void*)mk_fwd, dim3(grid), dim3(NTHREADS), args, LDS_BYTES, stream);
    if (e != hipSuccess) fprintf(stderr, "kernel_launch: cooperative launch failed: %s (grid %d)\n", hipGetErrorString(e), grid);
#else
    for (int p = 0; p < N_PHASES; ++p) { a.ph_lo = p; a.ph_hi = p + 1; hipLaunchKernelGGL(mk_fwd, dim3(grid), dim3(NTHREADS), LDS_BYTES, stream, a); }
#endif
}
```

```cpp
#include <hip/hip_runtime.h>
#include <hip/hip_cooperative_groups.h>
#include <cstdio>
#include <cstdint>
namespace cg = cooperative_groups;

constexpr int DM = 2048, NB = 4, SEQ = 4096, T = NB * SEQ, DEPTH = 2;
constexpr int NH = 8, QKD = 192, VD = 128, QL = 512, KVL = 256, DC = 1024, CK = 31;
constexpr int INC = 4928, INCP = 5120;
constexpr int Z_KVL = 512, Z_KR = 768, Z_MG = 832, Z_CV = 1856, Z_CGL = 2880, Z_CG = 3904;
constexpr int KQ = 512, KK = 384, KV = 256;
constexpr float EPS = 1e-6f;

template <int K> __device__ __forceinline__ float xshfl(float v) { static_assert(K >= 1 && K < 32, "xshfl"); return __int_as_float(__builtin_amdgcn_ds_swizzle(__float_as_int(v), (K << 10) | 0x1f)); }
__device__ __forceinline__ float xsum32(float v) { auto rr = __builtin_amdgcn_permlane32_swap(__float_as_uint(v), __float_as_uint(v), false, false); return __uint_as_float(rr[0]) + __uint_as_float(rr[1]); }
__device__ __forceinline__ float xswap32(float v, bool upper) { auto rr = __builtin_amdgcn_permlane32_swap(__float_as_uint(v), __float_as_uint(v), false, false); return __uint_as_float(upper ? rr[0] : rr[1]); }
__device__ __forceinline__ float wave_sum(float v) { v += xshfl<1>(v); v += xshfl<2>(v); v += xshfl<4>(v); v += xshfl<8>(v); v += xshfl<16>(v); return xsum32(v); }
namespace pg8 {
#define PG8_LAS __attribute__((address_space(3)))
typedef unsigned short bf16_t;
typedef short bf16x8 __attribute__((ext_vector_type(8)));
typedef float f32x4 __attribute__((ext_vector_type(4)));
typedef unsigned u32x4 __attribute__((ext_vector_type(4)));
constexpr int BM = 256, BK = 64, HALF = 128, HTB = HALF * BK * 2  , STAGE_BYTES = 8 * HTB, NXCD = 8, WGM = 4;

__host__ __device__ __forceinline__ int lds_byte(int r, int c) { const int st = (r >> 4) * 2 + (c >> 5), rr = r & 15, cc = c & 31, ob = rr * 64 + cc * 2; return st * 1024 + (ob ^ (((ob >> 9) & 1) << 5)); }
__host__ __device__ __forceinline__ void stage_rc(int b, int& R, int& C) { const int st = b / 1024, sb = b % 1024, swz = sb ^ (((sb >> 9) & 1) << 5); R = (st >> 1) * 16 + swz / 64; C = (st & 1) * 32 + (swz % 64) / 2; }
__host__ __device__ __forceinline__ int perm32(int rho) { const int n = rho >> 4, i = rho & 15; return 8 * (i >> 2) + 4 * n + (i & 3); }

struct Unit { int pm, pn; };
struct Gemm { const bf16_t* A; const bf16_t* Bt; int M, N, K, lda, ldb; };

struct StaticOrder {
    int nM, nN, nwg, G, c, wgm;
    __host__ __device__ void init(int M, int N, int G_, int c_, int wgm_ = WGM) { nM = M / BM; nN = N / BM; nwg = nM * nN; G = G_; c = c_; wgm = wgm_; }
    __host__ __device__ bool next(int i, Unit& u) const {
        const int L = i * G + c; if (L >= nwg) return false;
        int wgid = L; { const int q = nwg / NXCD, r = nwg % NXCD, xcd = wgid % NXCD, off = wgid / NXCD; wgid = (xcd < r ? xcd * (q + 1) : r * (q + 1) + (xcd - r) * q) + off; }
        const int nig = wgm * nN, gid = wgid / nig, fm = gid * wgm, gsz = (nM - fm) < wgm ? (nM - fm) : wgm;
        u.pm = fm + ((wgid % nig) % gsz); u.pn = (wgid % nig) / gsz; return true;
    }
    __device__ __forceinline__ void a_ready(const Unit&) const {}
    __device__ __forceinline__ void done(const Unit&) const {}
};
__device__ __forceinline__ unsigned cvt_pk_bf16(float lo, float hi) { unsigned r; asm volatile("v_cvt_pk_bf16_f32 %0, %1, %2" : "=v"(r) : "v"(lo), "v"(hi)); return r; }
typedef float f32x2 __attribute__((ext_vector_type(2)));
typedef unsigned u32x2 __attribute__((ext_vector_type(2)));
__device__ __forceinline__ float fast_silu(float v) { return v * __builtin_amdgcn_rcpf(1.0f + __builtin_amdgcn_exp2f(-1.4426950408889634f * v)); }
__device__ __forceinline__ float bf_lo(unsigned u) { return __uint_as_float(u << 16); }
__device__ __forceinline__ float bf_hi(unsigned u) { return __uint_as_float(u & 0xffff0000u); }

struct EpiZ {
    static constexpr bool PERM = true, AFTER_DRAIN = false;
    bf16_t* O; int ldc; const float* bias; int nvalid; float* ssq;
    __device__ __forceinline__ void operator()(const f32x4 (&acc)[2][2][4][2], const Unit& u, int wr, int wc, int fr, int fq) const {
        asm volatile("" : "+v"(fr), "+v"(fq), "+s"(wr), "+s"(wc));
        const int row0 = u.pm * BM + wr * 64 + fr; const int col0 = u.pn * BM + wc * 32 + 8 * fq;
        f32x4 bv[2][2];
#pragma unroll
        for (int bj = 0; bj < 2; ++bj)
#pragma unroll
            for (int n = 0; n < 2; ++n) bv[bj][n] = *(const f32x4*)(bias + col0 + bj * HALF + 4 * n);
        if (u.pn < 3) {
#pragma unroll
            for (int ai = 0; ai < 2; ++ai)
#pragma unroll
                for (int m = 0; m < 4; ++m) { float s = 0.f;
#pragma unroll
                    for (int bj = 0; bj < 2; ++bj)
#pragma unroll
                        for (int n = 0; n < 2; ++n) { const f32x4 x = acc[ai][bj][m][n] + bv[bj][n]; s += (x[0] * x[0] + x[1] * x[1]) + (x[2] * x[2] + x[3] * x[3]); }
                    s += xshfl<16>(s); s = xsum32(s);
                    if (fq == 0) ssq[(size_t)(row0 + ai * HALF + m * 16) * 12 + u.pn * 4 + wc] = s; }
        }
#pragma unroll
        for (int ai = 0; ai < 2; ++ai)
#pragma unroll
            for (int m = 0; m < 4; ++m) { bf16_t* rowp = O + (size_t)(row0 + ai * HALF + m * 16) * ldc + col0;
#pragma unroll
                for (int bj = 0; bj < 2; ++bj) { const f32x4 v0 = acc[ai][bj][m][0] + bv[bj][0], v1 = acc[ai][bj][m][1] + bv[bj][1];
                    u32x4 w; w.x = cvt_pk_bf16(v0[0], v0[1]); w.y = cvt_pk_bf16(v0[2], v0[3]); w.z = cvt_pk_bf16(v1[0], v1[1]); w.w = cvt_pk_bf16(v1[2], v1[3]);
                    if (col0 + bj * HALF < nvalid) __builtin_nontemporal_store(w, (u32x4*)(rowp + bj * HALF)); } }
    }
};
struct EpiV {
    static constexpr bool PERM = false, AFTER_DRAIN = false;
    bf16_t* O; const float* ssq;
    __device__ __forceinline__ void operator()(const f32x4 (&acc)[2][2][4][2], const Unit& u, int wr, int wc, int fr, int fq) const {
        asm volatile("" : "+v"(fr), "+v"(fq), "+s"(wr), "+s"(wc));
        const int t0 = u.pm * BM, b = t0 / SEQ, s0 = t0 % SEQ;
        float rk8[2][4];
#pragma unroll
        for (int ai = 0; ai < 2; ++ai)
#pragma unroll
            for (int m = 0; m < 4; ++m) { const f32x4 sl = *(const f32x4*)(ssq + (size_t)(t0 + ai * HALF + wr * 64 + m * 16 + fr) * 12 + 8);
                rk8[ai][m] = __builtin_amdgcn_rsqf(((sl[0] + sl[1]) + (sl[2] + sl[3])) * (1.0f / 256.0f) + 1e-6f); }
#pragma unroll
        for (int ai = 0; ai < 2; ++ai)
#pragma unroll
            for (int m = 0; m < 4; ++m) { const int r = ai * HALF + wr * 64 + m * 16 + fr;
                const float rk = rk8[ai][m];
#pragma unroll
                for (int bj = 0; bj < 2; ++bj) { bf16_t* dst = O + ((size_t)((b * NH + 2 * u.pn + bj) * SEQ + s0 + r)) * VD + wc * 32 + 4 * fq;
#pragma unroll
                    for (int n = 0; n < 2; ++n) { const f32x4 v = acc[ai][bj][m][n] * rk; u32x2 w; w.x = cvt_pk_bf16(v[0], v[1]); w.y = cvt_pk_bf16(v[2], v[3]); *(u32x2*)(dst + 16 * n) = w; } } }
    }
};
struct EpiPw {
    static constexpr bool PERM = true, AFTER_DRAIN = false;
    bf16_t* mix; const bf16_t* z; const float* bpw;
    __device__ __forceinline__ void operator()(const f32x4 (&acc)[2][2][4][2], const Unit& u, int wr, int wc, int fr, int fq) const {
        asm volatile("" : "+v"(fr), "+v"(fq), "+s"(wr), "+s"(wc));
        const int col0 = u.pn * BM + wc * 32 + 8 * fq;
        f32x4 bv[2][2];
#pragma unroll
        for (int bj = 0; bj < 2; ++bj)
#pragma unroll
            for (int n = 0; n < 2; ++n) bv[bj][n] = *(const f32x4*)(bpw + col0 + bj * HALF + 4 * n);
#pragma unroll
        for (int ai = 0; ai < 2; ++ai)
#pragma unroll
            for (int m = 0; m < 4; ++m) { const size_t t = (size_t)(u.pm * BM + ai * HALF + wr * 64 + m * 16 + fr);
#pragma unroll
                for (int bj = 0; bj < 2; ++bj) { const int c = col0 + bj * HALF; const u32x4 gz = __builtin_nontemporal_load((const u32x4*)(z + t * INC + Z_CG + c));
                    const f32x4 v0 = acc[ai][bj][m][0] + bv[bj][0], v1 = acc[ai][bj][m][1] + bv[bj][1];
                    u32x4 w; w.x = cvt_pk_bf16(v0[0] * fast_silu(bf_lo(gz.x)), v0[1] * fast_silu(bf_hi(gz.x))); w.y = cvt_pk_bf16(v0[2] * fast_silu(bf_lo(gz.y)), v0[3] * fast_silu(bf_hi(gz.y)));
                    w.z = cvt_pk_bf16(v1[0] * fast_silu(bf_lo(gz.z)), v1[1] * fast_silu(bf_hi(gz.z))); w.w = cvt_pk_bf16(v1[2] * fast_silu(bf_lo(gz.w)), v1[3] * fast_silu(bf_hi(gz.w)));
                    *(u32x4*)(mix + t * DM + DC + c) = w; }
                if (m & 1) asm volatile("" ::: "memory"); }
    }
};
struct EpiOut {
    static constexpr bool PERM = true, AFTER_DRAIN = false;
    const float* xin; float* xout; const float* gate;
    __device__ __forceinline__ void operator()(const f32x4 (&acc)[2][2][4][2], const Unit& u, int wr, int wc, int fr, int fq) const {
        asm volatile("" : "+v"(fr), "+v"(fq), "+s"(wr), "+s"(wc));
        const int col0 = u.pn * BM + wc * 32 + 8 * fq; const int b = (u.pm * BM) / SEQ;
        f32x4 gv[2][2];
#pragma unroll
        for (int bj = 0; bj < 2; ++bj)
#pragma unroll
            for (int n = 0; n < 2; ++n) gv[bj][n] = *(const f32x4*)(gate + (size_t)b * 6144 + col0 + bj * HALF + 4 * n);
#pragma unroll
        for (int ai = 0; ai < 2; ++ai)
#pragma unroll
            for (int m = 0; m < 4; ++m) { const size_t off = (size_t)(u.pm * BM + ai * HALF + wr * 64 + m * 16 + fr) * DM + col0;
#pragma unroll
                for (int bj = 0; bj < 2; ++bj)
#pragma unroll
                    for (int n = 0; n < 2; ++n) { const f32x4 xv = *(const f32x4*)(xin + off + bj * HALF + 4 * n);
                        *(f32x4*)(xout + off + bj * HALF + 4 * n) = xv + gv[bj][n] * acc[ai][bj][m][n]; }
                if (m == 3) asm volatile("" ::: "memory"); }
    }
};
struct EpiHead {
    static constexpr bool PERM = true, AFTER_DRAIN = false;
    bf16_t* O; const float* g; const float* cs; const float* sn; PG8_LAS float* P; const float* ssq; int qmode;
    __device__ __forceinline__ void operator()(const f32x4 (&acc)[2][2][4][2], const Unit& u, int wr, int wc, int fr, int fq) const {
        asm volatile("" : "+v"(fr), "+v"(fq), "+s"(wr), "+s"(wc));
        float rl8[2][4];
#pragma unroll
        for (int ai = 0; ai < 2; ++ai)
#pragma unroll
            for (int m = 0; m < 4; ++m) { const float* sp = ssq + (size_t)(u.pm * BM + ai * HALF + wr * 64 + m * 16 + fr) * 12; float lat;
                if (qmode) { const f32x4 a4 = *(const f32x4*)sp, b4 = *(const f32x4*)(sp + 4); lat = (((a4[0] + a4[1]) + (a4[2] + a4[3])) + ((b4[0] + b4[1]) + (b4[2] + b4[3]))) * (1.0f / 512.0f); }
                else { const f32x4 a4 = *(const f32x4*)(sp + 8); lat = ((a4[0] + a4[1]) + (a4[2] + a4[3])) * (1.0f / 256.0f); }
                rl8[ai][m] = __builtin_amdgcn_rsqf(lat + 1e-6f); }
#pragma unroll
        for (int ai = 0; ai < 2; ++ai)
#pragma unroll
            for (int m = 0; m < 4; ++m) { float s0 = 0.f, s1 = 0.f;
#pragma unroll
                for (int n = 0; n < 2; ++n) { const f32x4 x = acc[ai][0][m][n], y = acc[ai][1][m][n];
                    s0 += (x[0] * x[0] + x[1] * x[1]) + (x[2] * x[2] + x[3] * x[3]); s1 += (y[0] * y[0] + y[1] * y[1]) + (y[2] * y[2] + y[3] * y[3]); }
                s0 += xshfl<16>(s0); s0 = xsum32(s0); s1 += xshfl<16>(s1); s1 = xsum32(s1);
                if (fq == 0) { PG8_LAS float* pp = P + ((ai * HALF + wr * 64 + m * 16 + fr) * 4 + wc) * 2; pp[0] = s0; pp[1] = s1; } }
        asm volatile("s_waitcnt lgkmcnt(0)" ::: "memory"); __builtin_amdgcn_s_barrier(); asm volatile("" ::: "memory");
        const int t0 = u.pm * BM, b = t0 / SEQ, s0r = t0 % SEQ, h = u.pn, e = 16 * wc + 4 * fq;
        f32x4 g0[2], g1 = {0.f, 0.f, 0.f, 0.f}, g2 = {0.f, 0.f, 0.f, 0.f};
#pragma unroll
        for (int n = 0; n < 2; ++n) g0[n] = *(const f32x4*)(g + wc * 32 + 8 * fq + 4 * n);
        if (wc < 2) { g1 = *(const f32x4*)(g + 128 + e); g2 = *(const f32x4*)(g + 160 + e); }
#pragma unroll
        for (int ai = 0; ai < 2; ++ai)
#pragma unroll
            for (int m = 0; m < 4; ++m) { const int r = ai * HALF + wr * 64 + m * 16 + fr;
                const f32x4 pa = *(const PG8_LAS f32x4*)(P + r * 8), pb = *(const PG8_LAS f32x4*)(P + r * 8 + 4);
                const float S0 = (pa[0] + pa[2]) + (pb[0] + pb[2]), S1 = (pa[1] + pa[3]) + (pb[1] + pb[3]);
                const float rl = rl8[ai][m], rr = qmode ? rl : 1.0f;
                const float f = __builtin_amdgcn_rsqf((rl * rl * S0 + rr * rr * S1) * (1.0f / 192.0f) + 1e-6f), fn = rl * f, fp = rr * f;
                bf16_t* dst = O + ((size_t)((b * NH + h) * SEQ + s0r + r)) * QKD;
                { const f32x4 v0 = acc[ai][0][m][0] * fn * g0[0], v1 = acc[ai][0][m][1] * fn * g0[1]; u32x4 w; w.x = cvt_pk_bf16(v0[0], v0[1]); w.y = cvt_pk_bf16(v0[2], v0[3]); w.z = cvt_pk_bf16(v1[0], v1[1]); w.w = cvt_pk_bf16(v1[2], v1[3]); *(u32x4*)(dst + wc * 32 + 8 * fq) = w; }
                if (wc < 2) { const size_t tt = (size_t)(t0 + r) * 32 + e; const f32x4 c4 = *(const f32x4*)(cs + tt), s4 = *(const f32x4*)(sn + tt);
                    const f32x4 x1 = acc[ai][1][m][0] * fp * g1, x2 = acc[ai][1][m][1] * fp * g2; const f32x4 o1 = x1 * c4 - x2 * s4, o2 = x2 * c4 + x1 * s4;
                    u32x2 w1, w2; w1.x = cvt_pk_bf16(o1[0], o1[1]); w1.y = cvt_pk_bf16(o1[2], o1[3]); w2.x = cvt_pk_bf16(o2[0], o2[1]); w2.y = cvt_pk_bf16(o2[2], o2[3]);
                    *(u32x2*)(dst + 128 + e) = w1; *(u32x2*)(dst + 160 + e) = w2; }
                if (m & 1) asm volatile("" ::: "memory"); }
    }
};
template <class Epi, class Sched, bool ALIGN_EPI = false, bool SP2 = false>
__device__ __forceinline__ void gemm_phase(PG8_LAS unsigned char* lds, const Gemm g, const Sched& S, const Epi& E) {
    int tid_ = threadIdx.x; asm volatile("" : "+v"(tid_));
    const int tid = tid_, wid = __builtin_amdgcn_readfirstlane(tid >> 6), lane = tid & 63, wr = wid >> 2, wc = wid & 3, fr = lane & 15, fq = lane >> 4;
    const int K = g.K, nt = K / BK;
    unsigned voffA[2], voffB[2];
#pragma unroll
    for (int i = 0; i < 2; ++i) { int R, C; stage_rc(tid * 16 + i * 8192, R, C); const int Rb = Epi::PERM ? ((R & ~31) + perm32(R & 31)) : R;
        voffA[i] = (unsigned)(R * g.lda + C) * 2u; voffB[i] = (unsigned)(Rb * g.ldb + C) * 2u; }
    const size_t kstep = (size_t)(BK * 2);
    const size_t hstepA = (size_t)HALF * g.lda * 2, hstepB = (size_t)HALF * g.ldb * 2;
    const size_t tstepA = 2 * hstepA, tstepB = 2 * hstepB;
    const unsigned ldsw = (unsigned)wid * 1024u;
    const int aoff = lds_byte(wr * 64 + fr, fq * 8), boff = lds_byte(wc * 32 + fr, fq * 8);
#define PG8_SA(b, h) (((b) * 2 + (h)) * HTB)
#define PG8_SB(b, h) ((4 + (b) * 2 + (h)) * HTB)
#define PG8_STAGE(bufoff, gbase, voff) do { _Pragma("unroll") for (int _i = 0; _i < 2; ++_i) \
        __builtin_amdgcn_global_load_lds((const unsigned*)((const char*)(gbase) + (voff)[_i]), (PG8_LAS unsigned*)(lds + (bufoff) + ldsw + _i * 8192), 16, 0, 0); } while (0)
#define PG8_LDA(dst, b, h) do { _Pragma("unroll") for (int m = 0; m < 4; ++m) _Pragma("unroll") for (int k = 0; k < 2; ++k) dst[m][k] = *(const PG8_LAS bf16x8*)(lds + PG8_SA(b, h) + aoff + m * 2048 + k * 1024); } while (0)
#define PG8_LDB(dst, b, h) do { _Pragma("unroll") for (int n = 0; n < 2; ++n) _Pragma("unroll") for (int k = 0; k < 2; ++k) dst[n][k] = *(const PG8_LAS bf16x8*)(lds + PG8_SB(b, h) + boff + n * 2048 + k * 1024); } while (0)
#define PG8_MMA(ai, bj, At, Bt) do { __builtin_amdgcn_s_setprio(1); _Pragma("unroll") for (int m = 0; m < 4; ++m) _Pragma("unroll") for (int n = 0; n < 2; ++n) _Pragma("unroll") for (int k = 0; k < 2; ++k) \
        acc[ai][bj][m][n] = __builtin_amdgcn_mfma_f32_16x16x32_bf16(Bt[n][k], At[m][k], acc[ai][bj][m][n], 0, 0, 0); __builtin_amdgcn_s_setprio(0); } while (0)
#define PG8_WAIT_V(n) asm volatile("s_waitcnt vmcnt(" #n ")" ::: "memory")
#define PG8_WAIT_L(n) asm volatile("s_waitcnt lgkmcnt(" #n ")" ::: "memory")
#define PG8_BAR __builtin_amdgcn_s_barrier()
#define PG8_SCHED __builtin_amdgcn_sched_barrier(0)
    Unit cur, nxt; int ui = 0;
    if (!S.next(0, cur)) return;
    f32x4 acc[2][2][4][2];
#pragma unroll
    for (int a = 0; a < 2; ++a)
#pragma unroll
        for (int b = 0; b < 2; ++b)
#pragma unroll
            for (int m = 0; m < 4; ++m)
#pragma unroll
                for (int n = 0; n < 2; ++n) acc[a][b][m][n] = (f32x4){0.f, 0.f, 0.f, 0.f};
    bf16x8 At[4][2], B0[2][2], B1[2][2];
    const char* cA = (const char*)g.A + (size_t)cur.pm * tstepA; const char* cB = (const char*)g.Bt + (size_t)cur.pn * tstepB;
    S.a_ready(cur);
    if constexpr (SP2) {
        PG8_STAGE(PG8_SB(0, 0), cB, voffB); PG8_STAGE(PG8_SB(0, 1), cB + hstepB, voffB); PG8_STAGE(PG8_SA(0, 0), cA, voffA); PG8_STAGE(PG8_SA(0, 1), cA + hstepA, voffA);
        if (wr == 1) PG8_BAR;
        PG8_WAIT_V(2); PG8_BAR;
        PG8_STAGE(PG8_SB(1, 0), cB + kstep, voffB); PG8_STAGE(PG8_SA(1, 0), cA + kstep, voffA); PG8_STAGE(PG8_SB(1, 1), cB + hstepB + kstep, voffB);
        PG8_WAIT_V(6); PG8_BAR;
    } else {
        PG8_STAGE(PG8_SB(0, 0), cB, voffB); PG8_STAGE(PG8_SA(0, 0), cA, voffA); PG8_STAGE(PG8_SB(0, 1), cB + hstepB, voffB); PG8_STAGE(PG8_SA(0, 1), cA + hstepA, voffA);
        if (wr == 1) PG8_BAR;
        PG8_WAIT_V(4); PG8_BAR;
        PG8_STAGE(PG8_SB(1, 0), cB + kstep, voffB); PG8_STAGE(PG8_SA(1, 0), cA + kstep, voffA); PG8_STAGE(PG8_SB(1, 1), cB + hstepB + kstep, voffB);
        PG8_WAIT_V(6); PG8_BAR;
    }
    for (;;) {
        const bool has_next = S.next(ui + 1, nxt);
        const char* nA = has_next ? (const char*)g.A + (size_t)nxt.pm * tstepA : cA; const char* nB = has_next ? (const char*)g.Bt + (size_t)nxt.pn * tstepB : cB;
        for (int t = 0; t < nt; t += 2) {
            const bool last = (t == nt - 2);
            const char* a1 = cA + (size_t)(t + 1) * kstep;
            const char* a2 = last ? nA : cA + (size_t)(t + 2) * kstep; const char* b2 = last ? nB : cB + (size_t)(t + 2) * kstep;
            const char* a3 = a2 + kstep; const char* b3 = b2 + kstep;
            if (last && has_next) S.a_ready(nxt);
            if constexpr (SP2) {
            PG8_LDB(B0, 0, 0); PG8_LDB(B1, 0, 1); PG8_SCHED; PG8_LDA(At, 0, 0); PG8_STAGE(PG8_SA(1, 1), a1 + hstepA, voffA);
            PG8_WAIT_V(8); PG8_WAIT_L(0); PG8_BAR; PG8_MMA(0, 0, At, B0); PG8_MMA(0, 1, At, B1); PG8_BAR; PG8_SCHED;
            PG8_LDA(At, 0, 1); PG8_STAGE(PG8_SB(0, 0), b2, voffB); PG8_STAGE(PG8_SB(0, 1), b2 + hstepB, voffB); PG8_STAGE(PG8_SA(0, 0), a2, voffA);
            PG8_WAIT_V(8); PG8_WAIT_L(0); PG8_BAR; PG8_MMA(1, 0, At, B0); PG8_MMA(1, 1, At, B1); PG8_BAR; PG8_SCHED;
            PG8_LDB(B0, 1, 0); PG8_LDB(B1, 1, 1); PG8_SCHED; PG8_LDA(At, 1, 0); PG8_STAGE(PG8_SA(0, 1), a2 + hstepA, voffA);
            PG8_WAIT_V(8); PG8_WAIT_L(0); PG8_BAR; PG8_MMA(0, 0, At, B0); PG8_MMA(0, 1, At, B1); PG8_BAR; PG8_SCHED;
            PG8_LDA(At, 1, 1); PG8_STAGE(PG8_SB(1, 0), b3, voffB); PG8_STAGE(PG8_SB(1, 1), b3 + hstepB, voffB); PG8_STAGE(PG8_SA(1, 0), a3, voffA);
            PG8_WAIT_V(8); PG8_WAIT_L(0); PG8_BAR; PG8_MMA(1, 0, At, B0); PG8_MMA(1, 1, At, B1); PG8_BAR; PG8_SCHED;
            } else {
            PG8_LDB(B0, 0, 0); PG8_SCHED; PG8_LDA(At, 0, 0); PG8_STAGE(PG8_SA(1, 1), a1 + hstepA, voffA);
            PG8_WAIT_L(8); PG8_BAR; PG8_WAIT_L(0); PG8_MMA(0, 0, At, B0); PG8_BAR; PG8_SCHED;
            PG8_LDB(B1, 0, 1); PG8_STAGE(PG8_SB(0, 0), b2, voffB);
            PG8_BAR; PG8_WAIT_L(0); PG8_MMA(0, 1, At, B1); PG8_BAR;
            PG8_LDA(At, 0, 1); PG8_STAGE(PG8_SA(0, 0), a2, voffA);
            PG8_BAR; PG8_WAIT_L(0); PG8_MMA(1, 0, At, B0); PG8_BAR; PG8_SCHED;
            PG8_STAGE(PG8_SB(0, 1), b2 + hstepB, voffB);
            PG8_WAIT_V(6); PG8_BAR; PG8_MMA(1, 1, At, B1); PG8_BAR;
            PG8_LDB(B0, 1, 0); PG8_SCHED; PG8_LDA(At, 1, 0); PG8_STAGE(PG8_SA(0, 1), a2 + hstepA, voffA);
            PG8_WAIT_L(8); PG8_BAR; PG8_WAIT_L(0); PG8_MMA(0, 0, At, B0); PG8_BAR; PG8_SCHED;
            PG8_LDB(B1, 1, 1); PG8_STAGE(PG8_SB(1, 0), b3, voffB);
            PG8_BAR; PG8_WAIT_L(0); PG8_MMA(0, 1, At, B1); PG8_BAR;
            PG8_LDA(At, 1, 1); PG8_STAGE(PG8_SA(1, 0), a3, voffA);
            PG8_BAR; PG8_WAIT_L(0); PG8_MMA(1, 0, At, B0); PG8_BAR; PG8_SCHED;
            PG8_STAGE(PG8_SB(1, 1), b3 + hstepB, voffB);
            PG8_WAIT_V(6); PG8_BAR; PG8_MMA(1, 1, At, B1); PG8_BAR;
            }
        }
        if constexpr (ALIGN_EPI) { if (wr == 0) PG8_BAR; }
        if constexpr (!Epi::AFTER_DRAIN) { int t2_ = threadIdx.x; asm volatile("" : "+v"(t2_)); E(acc, cur, wr, wc, t2_ & 15, (t2_ & 63) >> 4); S.done(cur); }
        if (!has_next) break;
#pragma unroll
        for (int a = 0; a < 2; ++a)
#pragma unroll
            for (int b = 0; b < 2; ++b)
#pragma unroll
                for (int m = 0; m < 4; ++m)
#pragma unroll
                    for (int n = 0; n < 2; ++n) acc[a][b][m][n] = (f32x4){0.f, 0.f, 0.f, 0.f};
        cur = nxt; cA = nA; cB = nB; ++ui;
        if constexpr (ALIGN_EPI) { if (wr == 1) PG8_BAR; }
    }
    PG8_WAIT_V(0);
    if constexpr (!ALIGN_EPI) { if (wr == 0) PG8_BAR; }
    PG8_BAR;
    if constexpr (Epi::AFTER_DRAIN) { E.fused(acc, cur, wr, wc, fr, fq, lds, wid, lane); S.done(cur); }
#undef PG8_SA
#undef PG8_SB
#undef PG8_STAGE
#undef PG8_LDA
#undef PG8_LDB
#undef PG8_MMA
#undef PG8_WAIT_V
#undef PG8_WAIT_L
#undef PG8_BAR
#undef PG8_SCHED
}
}
namespace att {
#define ALAS __attribute__((address_space(3)))
typedef unsigned short bf16_t;
typedef short bf16x8 __attribute__((ext_vector_type(8)));
typedef short s16x4 __attribute__((ext_vector_type(4)));
typedef float f32x16 __attribute__((ext_vector_type(16)));
typedef float f32x4 __attribute__((ext_vector_type(4)));
typedef unsigned u32x4 __attribute__((ext_vector_type(4)));
constexpr int NW = 8, QBLK = 32, KVBLK = 64, QB = 256;
constexpr int KROW = 400;
constexpr int SHM_V = KVBLK * VD * 2, SHM_K = KVBLK * KROW;
constexpr int LDS_V = 0, LDS_K = 2 * SHM_V, LDS_WS = LDS_K + 2 * SHM_K, LDS_BYTES = LDS_WS + NW * 64 * 4;
constexpr float SCALE = 0.07216878364870323f;
constexpr float THR = 8.f;
#define SBAR() __builtin_amdgcn_sched_barrier(0)
__device__ __forceinline__ int v_st(int k, int c) { const int kk = (k & ~0xC) | ((k & 4) << 1) | ((k & 8) >> 1); return ((kk >> 3) * 4 + (c >> 5)) * 512 + ((kk & 7) * 32 + (c & 31)) * 2; }
__device__ __forceinline__ int v_rd_base(int lane) { return ((lane & 3) << 3) | (((lane >> 2) & 3) << 6) | (((lane >> 4) & 1) << 5) | (((lane >> 5) & 1) << 8); }
constexpr int v_rd_off(int d0, int ks, int half) { return d0 * 512 + ks * 4096 + half * 2048; }
__device__ __forceinline__ int crow(int r, int hi) { return (r & 3) + 8 * (r >> 2) + 4 * hi; }
__device__ __forceinline__ unsigned cvtpk(float lo, float hi) { unsigned r; asm volatile("v_cvt_pk_bf16_f32 %0, %1, %2" : "=v"(r) : "v"(lo), "v"(hi)); return r; }
__device__ __forceinline__ void mask_tile(f32x16& p0, f32x16& p1, int dq) {
    const float NEG = -__builtin_inff();
#pragma unroll
    for (int r = 0; r < 16; ++r) { const int c = (r & 3) + 8 * (r >> 2); if (dq - c < 0) p0[r] = NEG; if (dq - c - 32 < 0) p1[r] = NEG; }
}
__device__ __forceinline__ void partialSM(f32x16& p0, f32x16& p1, float& m_reg, float& mn, float& alpha) {
    float pmax = p0[0];
#pragma unroll
    for (int r = 1; r < 16; ++r) pmax = fmaxf(pmax, p0[r]);
#pragma unroll
    for (int r = 0; r < 16; ++r) pmax = fmaxf(pmax, p1[r]);
    { auto rr = __builtin_amdgcn_permlane32_swap(__float_as_uint(pmax), __float_as_uint(pmax), false, false); pmax = fmaxf(__uint_as_float(rr[0]), __uint_as_float(rr[1])); }
    constexpr float C2 = 1.4426950408889634f * SCALE;
    if (__builtin_expect(__all((pmax - m_reg) * SCALE <= THR), 1)) { mn = m_reg; alpha = 1.f; }
    else { mn = fmaxf(m_reg, pmax); alpha = __builtin_amdgcn_exp2f((m_reg - mn) * C2); m_reg = mn; }
    const float mnL = -mn * C2;
#pragma unroll
    for (int r = 0; r < 16; ++r) p0[r] = fmaf(p0[r], C2, mnL);
#pragma unroll
    for (int r = 0; r < 16; ++r) p1[r] = fmaf(p1[r], C2, mnL);
#pragma unroll
    for (int r = 0; r < 16; ++r) p0[r] = __builtin_amdgcn_exp2f(p0[r]);
}
__device__ __forceinline__ void finishSM(f32x16& p0, f32x16& p1, float alpha, float& l_reg, bf16x8& pa0, bf16x8& pa1, bf16x8& pa2, bf16x8& pa3) {
#pragma unroll
    for (int r = 0; r < 16; ++r) p1[r] = __builtin_amdgcn_exp2f(p1[r]);
    float ps = 0;
#pragma unroll
    for (int r = 0; r < 16; ++r) ps += p0[r];
#pragma unroll
    for (int r = 0; r < 16; ++r) ps += p1[r];
    { auto rr = __builtin_amdgcn_permlane32_swap(__float_as_uint(ps), __float_as_uint(ps), false, false); ps = __uint_as_float(rr[0]) + __uint_as_float(rr[1]); }
    l_reg = l_reg * alpha + ps;
#define PK4(P, B_, OUT) do { unsigned a0 = cvtpk(P[B_+0], P[B_+1]), a1 = cvtpk(P[B_+2], P[B_+3]);                          \
        unsigned b0 = cvtpk(P[B_+4], P[B_+5]), b1 = cvtpk(P[B_+6], P[B_+7]);                                             \
        auto r0 = __builtin_amdgcn_permlane32_swap(a0, b0, false, false); auto r1 = __builtin_amdgcn_permlane32_swap(a1, b1, false, false); \
        u32x4 w = {r0[0], r1[0], r0[1], r1[1]}; OUT = *reinterpret_cast<bf16x8*>(&w); } while (0)
    PK4(p0, 0, pa0); PK4(p0, 8, pa1); PK4(p1, 0, pa2); PK4(p1, 8, pa3);
#undef PK4
}
#ifndef QK_DEPTH
#define QK_DEPTH 6
#endif
template <int KB>
__device__ __forceinline__ void qkt(f32x16& p0, f32x16& p1, const ALAS char* kb, const bf16x8* qr) {
    p0 = f32x16{}; p1 = f32x16{};
#define KRD(f) (*(const ALAS bf16x8*)(kb + KB * SHM_K + ((f) >> 1) * 32 + ((f) & 1) * 32 * KROW))
    bf16x8 kf[QK_DEPTH];
#pragma unroll
    for (int f = 0; f < QK_DEPTH; ++f) kf[f] = KRD(f);
    SBAR();
#pragma unroll
    for (int f = 0; f < 24; ++f) {
        if (f & 1) p1 = __builtin_amdgcn_mfma_f32_32x32x16_bf16(kf[f % QK_DEPTH], qr[f >> 1], p1, 0, 0, 0);
        else       p0 = __builtin_amdgcn_mfma_f32_32x32x16_bf16(kf[f % QK_DEPTH], qr[f >> 1], p0, 0, 0, 0);
        if (f + QK_DEPTH < 24) kf[f % QK_DEPTH] = KRD(f + QK_DEPTH);
        SBAR();
    }
#undef KRD
}
template <int VB>
__device__ __forceinline__ void pv_tile(f32x16* o, int vb0, bf16x8 pa0, bf16x8 pa1, bf16x8 pa2, bf16x8 pa3) {
#define TRRD(dst, off) asm volatile("ds_read_b64_tr_b16 %0, %1 offset:%2" : "=&v"(dst) : "v"(vb0), "i"(off) : "memory")
#define PV_D0(d0) do { s16x4 l0, l1, l2, l3, h0, h1, h2, h3; constexpr int b_ = VB * SHM_V + v_rd_off(d0, 0, 0); \
        TRRD(l0, b_); TRRD(h0, b_ + 2048); TRRD(l1, b_ + 4096); TRRD(h1, b_ + 6144); TRRD(l2, b_ + 8192); TRRD(h2, b_ + 10240); TRRD(l3, b_ + 12288); TRRD(h3, b_ + 14336); \
        asm volatile("s_waitcnt lgkmcnt(0)" ::: "memory"); SBAR(); \
        o[d0] = __builtin_amdgcn_mfma_f32_32x32x16_bf16(pa0, (bf16x8){l0[0], l0[1], l0[2], l0[3], h0[0], h0[1], h0[2], h0[3]}, o[d0], 0, 0, 0);   \
        o[d0] = __builtin_amdgcn_mfma_f32_32x32x16_bf16(pa1, (bf16x8){l1[0], l1[1], l1[2], l1[3], h1[0], h1[1], h1[2], h1[3]}, o[d0], 0, 0, 0);   \
        o[d0] = __builtin_amdgcn_mfma_f32_32x32x16_bf16(pa2, (bf16x8){l2[0], l2[1], l2[2], l2[3], h2[0], h2[1], h2[2], h2[3]}, o[d0], 0, 0, 0);   \
        o[d0] = __builtin_amdgcn_mfma_f32_32x32x16_bf16(pa3, (bf16x8){l3[0], l3[1], l3[2], l3[3], h3[0], h3[1], h3[2], h3[3]}, o[d0], 0, 0, 0); } while (0)
    PV_D0(0); PV_D0(1); PV_D0(2); PV_D0(3);
#undef PV_D0
#undef TRRD
}
__device__ __forceinline__ float silu_f(float v) { return v * __builtin_amdgcn_rcpf(1.0f + __builtin_amdgcn_exp2f(-1.4426950408889634f * v)); }

__device__ __forceinline__ void attn_block(const bf16_t* __restrict__ Qh, const bf16_t* __restrict__ Kh, const bf16_t* __restrict__ Vh, int qb,
                                           bf16_t* __restrict__ mixp, const bf16_t* __restrict__ zg, ALAS char* lds) {
    int tid_ = threadIdx.x; asm volatile("" : "+v"(tid_));
    const int tid = tid_, wid = __builtin_amdgcn_readfirstlane(tid >> 6), lane = tid & 63, r32 = lane & 31, hi = lane >> 5;
    const int NT = 4 * (qb + 1);
    const int qlo = qb * QB + wid * QBLK, qm = qlo + r32 - 4 * hi;
    ALAS char* V_lds = lds + LDS_V; ALAS char* K_lds = lds + LDS_K;
    ALAS float* ws = (ALAS float*)(lds + LDS_WS) + wid * 64; ALAS float* li_l = ws; ALAS float* al_l = ws + 32;
    float m_reg = -1e30f, l_reg = 0; f32x16 o[4] = {};
    const int sr = tid >> 4, sc = (tid & 15) * 8, vst0 = v_st(sr, sc), vst1 = v_st(32 + sr, sc);
    int kld[3];
#pragma unroll
    for (int i = 0; i < 3; ++i) { const int ci = tid + 512 * i; kld[i] = (ci / 24) * KROW + (ci % 24) * 16; }
    const int vb0 = (int)(unsigned)(uintptr_t)V_lds + v_rd_base(lane);
    const ALAS char* kb = K_lds + r32 * KROW + hi * 16;
    bf16x8 qr[12];
#pragma unroll
    for (int d0 = 0; d0 < 12; ++d0) qr[d0] = *(const bf16x8*)((const char*)Qh + (unsigned)(((qlo + r32) * QKD + d0 * 16 + hi * 8) * 2));
    bf16x8 st_v0, st_v1, st_k0, st_k1, st_k2;
    const unsigned vof0 = (unsigned)((sr * VD + sc) * 2), vof1 = vof0 + 32 * VD * 2, kof0 = (unsigned)tid * 16u, kof1 = kof0 + 8192u, kof2 = kof0 + 16384u;
#define SLOAD(t) do { const char* vt_ = (const char*)Vh + (size_t)(t) * (KVBLK * VD * 2); const char* kt_ = (const char*)Kh + (size_t)(t) * (KVBLK * QKD * 2); \
        st_v0 = *(const bf16x8*)(vt_ + vof0); st_v1 = *(const bf16x8*)(vt_ + vof1); st_k0 = *(const bf16x8*)(kt_ + kof0); st_k1 = *(const bf16x8*)(kt_ + kof1); st_k2 = *(const bf16x8*)(kt_ + kof2); } while (0)
#define SWRITE(bf) do { *(ALAS bf16x8*)(V_lds + (bf) * SHM_V + vst0) = st_v0; *(ALAS bf16x8*)(V_lds + (bf) * SHM_V + vst1) = st_v1; \
        *(ALAS bf16x8*)(K_lds + (bf) * SHM_K + kld[0]) = st_k0; *(ALAS bf16x8*)(K_lds + (bf) * SHM_K + kld[1]) = st_k1; *(ALAS bf16x8*)(K_lds + (bf) * SHM_K + kld[2]) = st_k2; } while (0)
#define RESC(a) do { if (__any((a) < 1.f)) { if (hi == 0) al_l[r32] = (a); asm volatile("s_waitcnt lgkmcnt(0)" ::: "memory");              \
                     _Pragma("unroll") for (int d_ = 0; d_ < 4; ++d_) _Pragma("unroll") for (int r = 0; r < 16; ++r) o[d_][r] *= al_l[crow(r, hi)]; } } while (0)
#define MASKT(P0_, P1_, t) do { const int kb_ = (t) * KVBLK; if (kb_ + KVBLK - 1 > qlo) mask_tile(P0_, P1_, qm - kb_); } while (0)
    f32x16 p0, p1; float mn, al; bf16x8 pa0, pa1, pa2, pa3;
    SLOAD(0); SWRITE(0); SLOAD(1);
    __syncthreads();
#define STEP(t, KB) do { if ((t) + 1 < NT) { SWRITE(1 - KB); } if ((t) + 2 < NT) { SLOAD((t) + 2); } SBAR();            \
        qkt<KB>(p0, p1, kb, qr); MASKT(p0, p1, (t)); partialSM(p0, p1, m_reg, mn, al); RESC(al);                       \
        finishSM(p0, p1, al, l_reg, pa0, pa1, pa2, pa3); SBAR(); pv_tile<KB>(o, vb0, pa0, pa1, pa2, pa3);               \
        __syncthreads(); } while (0)
    for (int t = 0; t < NT; t += 2) { STEP(t, 0); STEP(t + 1, 1); }
#undef STEP
    if (hi == 0) li_l[r32] = l_reg; asm volatile("s_waitcnt lgkmcnt(0)" ::: "memory");
    { int le = lane; asm volatile("" : "+v"(le));
      const int r32e = le & 31, hie = le >> 5;
      ALAS char* stg = lds + wid * 8192;
#pragma unroll
      for (int r = 0; r < 16; ++r) { const int orow = crow(r, hie); const float rl = __builtin_amdgcn_rcpf(li_l[orow]);
#pragma unroll
          for (int d0 = 0; d0 < 4; ++d0) { const float v = o[d0][r] * rl; const float vn = xshfl<1>(v);
              if ((r32e & 1) == 0) *(ALAS unsigned*)(stg + orow * 256 + (d0 * 32 + r32e) * 2) = cvtpk(v, vn); } }
      asm volatile("s_waitcnt lgkmcnt(0)" ::: "memory");
#pragma unroll
      for (int i = 0; i < 8; ++i) { const int c = le + 64 * i, row = c >> 4, ch = c & 15;
          const u32x4 ov = *(const ALAS u32x4*)(stg + row * 256 + ch * 16);
          const u32x4 gz = __builtin_nontemporal_load((const u32x4*)((const char*)zg + (unsigned)(((qlo + row) * INC + ch * 8) * 2)));
#define GM(O_, G_) cvtpk(__uint_as_float((O_) << 16) * silu_f(__uint_as_float((G_) << 16)), __uint_as_float((O_) & 0xffff0000u) * silu_f(__uint_as_float((G_) & 0xffff0000u)))
          u32x4 w; w.x = GM(ov.x, gz.x); w.y = GM(ov.y, gz.y); w.z = GM(ov.z, gz.z); w.w = GM(ov.w, gz.w);
#undef GM
          *(u32x4*)((char*)mixp + (unsigned)(((qlo + row) * DM + ch * 8) * 2)) = w; } }
    __syncthreads();
#undef SLOAD
#undef SWRITE
#undef RESC
#undef MASKT
}
#undef SBAR
}
#define LAS __attribute__((address_space(3)))
#define CAS __attribute__((address_space(4)))
typedef unsigned short bf16_t;
typedef float f32x4 __attribute__((ext_vector_type(4)));
typedef float f32x2 __attribute__((ext_vector_type(2)));
typedef unsigned u32x4 __attribute__((ext_vector_type(4)));
typedef unsigned u32x2 __attribute__((ext_vector_type(2)));
using pg8::cvt_pk_bf16; using pg8::bf_lo; using pg8::bf_hi; using pg8::fast_silu;

constexpr int NWAVES = 8, NTHREADS = 512;
constexpr int RING_BYTES = 131072, EXCH_OFF = RING_BYTES, BST_OFF = EXCH_OFF + 8192, LDS_BYTES = BST_OFF + 64;
constexpr int PH_PER_LAYER = 5, N_PHASES = 1 + PH_PER_LAYER * DEPTH;
#ifndef EN_P0
#define EN_P0 1
#endif
#ifndef EN_A
#define EN_A 1
#endif
#ifndef EN_B
#define EN_B 1
#endif
#ifndef EN_C1
#define EN_C1 1
#endif
#ifndef EN_C2
#define EN_C2 1
#endif
#ifndef EN_D
#define EN_D 1
#endif
#ifndef EN_E
#define EN_E 1
#endif
#ifndef EN_ATT
#define EN_ATT 1
#endif
#ifndef EN_PW
#define EN_PW 1
#endif
#ifndef REP_P0
#define REP_P0 1
#endif
#ifndef REP_A
#define REP_A 1
#endif
#ifndef REP_B
#define REP_B 1
#endif
#ifndef REP_C1
#define REP_C1 1
#endif
#ifndef REP_C2
#define REP_C2 1
#endif
#ifndef REP_ATT
#define REP_ATT 1
#endif
#ifndef REP_PW
#define REP_PW 1
#endif
#ifndef REP_E0
#define REP_E0 1
#endif
#ifndef REP_LAT
#define REP_LAT 1
#endif
#ifndef REP_CONV
#define REP_CONV 1
#endif
#ifndef REP_GEMV
#define REP_GEMV 1
#endif
#ifndef REP_CVT
#define REP_CVT 1
#endif
#ifndef WGM_B
#define WGM_B 5
#endif
#ifndef WGM_E
#define WGM_E 2
#endif
#ifndef WGM_QK
#define WGM_QK 8
#endif
#ifndef WGM_V
#define WGM_V 4
#endif
#ifndef WGM_PW
#define WGM_PW 4
#endif
#ifndef MK_ONE_LAUNCH
#define MK_ONE_LAUNCH 1
#endif

constexpr size_t MiB = 1u << 20;
constexpr size_t WS_MOD = 1 * MiB;
constexpr size_t WS_BIAS = WS_MOD + 256 * 1024;
constexpr size_t WS_COS = 2 * MiB, WS_SIN = 4 * MiB;
constexpr size_t WS_WIN = 6 * MiB;
constexpr size_t WS_WQ = 46 * MiB;
constexpr size_t WS_WK = 50 * MiB;
constexpr size_t WS_WV = 53 * MiB;
constexpr size_t WS_WPW = 54 * MiB;
constexpr size_t WS_WOUT = 58 * MiB;
constexpr size_t WS_H = 74 * MiB;
constexpr size_t WS_Z = 138 * MiB;
constexpr size_t WS_SSQ = 292 * MiB;
constexpr size_t WS_Q = 320 * MiB, WS_K = 368 * MiB;
constexpr size_t WS_V = 416 * MiB;
constexpr size_t WS_U2 = 448 * MiB;
constexpr size_t WS_END = 480 * MiB;

__device__ __forceinline__ float fast_sigmoid(float v) { return __builtin_amdgcn_rcpf(1.0f + __builtin_amdgcn_exp2f(-1.4426950408889634f * v)); }

#define XB_TMO      128
#define XB_XCNT(j)  (256  + 64 * (j))
#define XB_XSUB(j)  (1280 + 64 * (j))
#define XB_XGEN(j)  (2304 + 64 * (j))
#define XB_TOP      3328
#define XB_TOPGEN   3392
#define XCD_BAR_WORDS 3456
#define XB_SPIN_CAP (1u << 18)

__device__ __forceinline__ unsigned xb_ld(unsigned* p)              { return __hip_atomic_load(p, __ATOMIC_RELAXED, __HIP_MEMORY_SCOPE_AGENT); }
__device__ __forceinline__ unsigned xb_add(unsigned* p, unsigned v) { return __hip_atomic_fetch_add(p, v, __ATOMIC_RELAXED, __HIP_MEMORY_SCOPE_AGENT); }
__device__ __forceinline__ unsigned xb_xcc_id() { return (unsigned)__builtin_amdgcn_s_getreg((3 << 11) | 20) & 0xFu; }
#define XB_SPIN(cond, bar) do { unsigned _sp = 0; while (cond) { __builtin_amdgcn_s_sleep(1); \
    if ((++_sp & 255u) == 0u) { if (xb_ld(&(bar)[XB_TMO])) break; if (_sp > XB_SPIN_CAP) { atomicAdd(&(bar)[XB_TMO], 1u); break; } } } } while (0)

struct XcdBarrier {
    unsigned* bar; unsigned x;
    volatile LAS unsigned* st;
};

__device__ __forceinline__ XcdBarrier xcd_barrier_post(unsigned* bar, volatile LAS unsigned* st) {
    XcdBarrier b; b.bar = bar; b.x = xb_xcc_id(); b.st = st;
    if (threadIdx.x == 0) (void)xb_add(&bar[XB_XCNT(b.x)], 1u);
    return b;
}
__device__ __forceinline__ void xcd_barrier_complete(unsigned* bar, unsigned x, unsigned& nloc, unsigned& nx) {
    const unsigned G = gridDim.x * gridDim.y * gridDim.z;
    unsigned sum, cnt, mine, sp = 0u;
    for (;;) {
        sum = 0u; cnt = 0u; mine = 0u;
#pragma unroll
        for (unsigned j = 0; j < 16; ++j) { const unsigned c = xb_ld(&bar[XB_XCNT(j)]); sum += c; cnt += (c > 0u) ? 1u : 0u; mine = (j == x) ? c : mine; }
        if (sum == G) break;
        __builtin_amdgcn_s_sleep(1);
        if ((++sp & 255u) == 0u) { if (xb_ld(&bar[XB_TMO])) break; if (sp > XB_SPIN_CAP) { atomicAdd(&bar[XB_TMO], 1u); break; } }
    }
    nloc = mine > 0u ? mine : 1u; nx = cnt > 0u ? cnt : 1u;
}

__device__ __forceinline__ void xcd_barrier(const XcdBarrier& b) {
    asm volatile("s_waitcnt vmcnt(0)" ::: "memory");
    __syncthreads();
    if (threadIdx.x == 0) {
        unsigned* bar = b.bar;
        __builtin_amdgcn_s_waitcnt(0);
        unsigned nloc = b.st[0], nx = b.st[1];
        if (nloc == 0u) { xcd_barrier_complete(bar, b.x, nloc, nx); b.st[0] = nloc; b.st[1] = nx; }
        const unsigned old = xb_add(&bar[XB_XSUB(b.x)], 1u);
        const unsigned gen = old / nloc;
        if (old + 1u == (gen + 1u) * nloc) {
            __builtin_amdgcn_fence(__ATOMIC_RELEASE, "agent");
            asm volatile("s_waitcnt vmcnt(0)" ::: "memory");
            const unsigned og = xb_add(&bar[XB_TOP], 1u);
            const unsigned tg = og / nx;
            if (og + 1u == (tg + 1u) * nx) xb_add(&bar[XB_TOPGEN], 1u);
            else XB_SPIN(xb_ld(&bar[XB_TOPGEN]) == tg, bar);
            __builtin_amdgcn_fence(__ATOMIC_ACQUIRE, "agent");
            xb_add(&bar[XB_XGEN(b.x)], 1u);
            asm volatile("s_waitcnt vmcnt(0)" ::: "memory");
        } else {
            XB_SPIN(xb_ld(&bar[XB_XGEN(b.x)]) == gen, bar);
            __builtin_amdgcn_fence(__ATOMIC_ACQUIRE, "agent");
            asm volatile("s_waitcnt vmcnt(0)" ::: "memory");
        }
    }
    __syncthreads();
}

__device__ __forceinline__ int hmap(int c) {
    if (c < 128) return c;
    if (c >= 192) return -1;
    const int q = c - 128, wc = q >> 5, fq = (q >> 3) & 3, n = (q >> 2) & 1, j = q & 3;
    return 128 + 32 * n + 16 * wc + 4 * fq + j;
}
__device__ __forceinline__ void cvt_load(float (&v)[32], const float* __restrict__ W, const float* __restrict__ gk, int Nsrc, int Ksrc, int col, int idk, int k0, int lane) {
#pragma unroll
    for (int i = 0; i < 32; ++i) { const int k = k0 + 2 * i + (lane >> 5); float x = 0.f;
        if (col >= 0 && k < Ksrc) { x = __builtin_nontemporal_load(W + (size_t)k * Nsrc + col); if (gk) x *= gk[k]; }
        if (k == idk) x = 1.f;
        v[i] = x; }
}
__device__ __forceinline__ void cvt_store(const float (&v)[32], bf16_t* __restrict__ WT, int Kout, int n0, int k0, LAS float* scr, int lane) {
#pragma unroll
    for (int i = 0; i < 32; ++i) scr[(2 * i + (lane >> 5)) * 33 + (lane & 31)] = v[i];
    asm volatile("s_waitcnt lgkmcnt(0)" ::: "memory");
    const int c = lane & 7;
#pragma unroll
    for (int j = 0; j < 4; ++j) { const int n = (lane >> 3) + 8 * j; const LAS float* s = scr + (8 * c) * 33 + n;
        u32x4 o; o.x = cvt_pk_bf16(s[0 * 33], s[1 * 33]); o.y = cvt_pk_bf16(s[2 * 33], s[3 * 33]); o.z = cvt_pk_bf16(s[4 * 33], s[5 * 33]); o.w = cvt_pk_bf16(s[6 * 33], s[7 * 33]);
        *(u32x4*)(WT + (size_t)(n0 + n) * Kout + k0 + 8 * c) = o; }
    asm volatile("s_waitcnt lgkmcnt(0)" ::: "memory");
}
struct CvtDst { bf16_t* WT; int Kout, n0, k0; };

template <int SI> __device__ __forceinline__ void conv_step(f32x2 (&av)[32], const f32x2 (&wv)[CK], const f32x2 u) {
#pragma unroll
    for (int tt = 0; tt < 32; ++tt) { const int j = SI - tt; if (j >= 0 && j <= 30) av[tt] = wv[j] * u + av[tt]; }
}

struct Args { const float* in[21]; float* out; unsigned char* ws; int ph_lo, ph_hi; };

__global__ void __launch_bounds__(NTHREADS, 2) mk_fwd(Args a) {
    extern __shared__ __attribute__((aligned(16))) unsigned char lds_raw[];
    LAS unsigned char* lds = (LAS unsigned char*)lds_raw;
    cg::grid_group grid = cg::this_grid();
    const int lo = a.ph_lo, hi = a.ph_hi;
    volatile LAS unsigned* bst = (volatile LAS unsigned*)(lds + BST_OFF);
    if (threadIdx.x < 2) bst[threadIdx.x] = 0u;
    __syncthreads();
    XcdBarrier xbar; xbar.bar = (unsigned*)a.ws; xbar.x = 0; xbar.st = bst;
    if (hi - lo > 1) xbar = xcd_barrier_post((unsigned*)a.ws, bst);
#define PHASE_BEGIN() \
    const CAS Args* ap = (const CAS Args*)__builtin_amdgcn_kernarg_segment_ptr(); asm volatile("" : "+s"(ap)); \
    int tid = threadIdx.x; asm volatile("" : "+v"(tid)); \
    const int lane = tid & 63, wave = __builtin_amdgcn_readfirstlane(tid >> 6); \
    int G = gridDim.x, bx = blockIdx.x; asm volatile("" : "+s"(G), "+s"(bx)); \
    const int gw = bx * NWAVES + wave, NGW = G * NWAVES; \
    unsigned char* ws = ap->ws; (void)lane; (void)gw; (void)NGW; (void)ws;
#define INP(i) (ap->in[i])
#define IN(k) (lo <= (k) && (k) < hi)
#ifndef USE_CG_SYNC
#define USE_CG_SYNC 0
#endif
#define SEAM(k) do { if (IN(k) && IN((k) + 1)) { if (USE_CG_SYNC || (k) == 0) grid.sync(); else xcd_barrier(xbar); } } while (0)

    for (int rep_ = 0; rep_ < REP_P0; ++rep_) if (EN_P0 && IN(0)) {
        PHASE_BEGIN();
        const float* c_in = INP(1); const int* positions = (const int*)INP(2); const float* ada_w = INP(3); const float* ada_b = INP(4); const float* w_in = INP(6);
        const float* w_q_up = INP(8); const float* w_kv_up = INP(10); const float* q_lat_g = INP(7); const float* kv_lat_g = INP(9); const float* glu_b = INP(13); const float* w_pw = INP(18); const float* w_out = INP(20);
        float* modb = (float*)(ws + WS_MOD); float* biasb = (float*)(ws + WS_BIAS); float* cosb = (float*)(ws + WS_COS); float* sinb = (float*)(ws + WS_SIN);
        bf16_t* Win_t = (bf16_t*)(ws + WS_WIN); bf16_t* Wq_t = (bf16_t*)(ws + WS_WQ); bf16_t* Wk_t = (bf16_t*)(ws + WS_WK); bf16_t* Wv_t = (bf16_t*)(ws + WS_WV);
        bf16_t* Wpw_t = (bf16_t*)(ws + WS_WPW); bf16_t* Wout_t = (bf16_t*)(ws + WS_WOUT);
        LAS float* scl = (LAS float*)lds;
        LAS float* red = (LAS float*)(lds + 32768);
        { for (int i = tid; i < NB * DM; i += NTHREADS) { const int b = i / DM, k = i % DM; scl[k * 4 + b] = fast_silu(c_in[i]); } __syncthreads(); }
        for (int rg_ = 0; rg_ < REP_GEMV; ++rg_) for (int task = bx; task < 256; task += G) {
            const int l = task >> 7, col = (task & 127) * 48 + (lane < 48 ? lane : 47);
            const float* wp = ada_w + (size_t)l * DM * 6144 + (size_t)(wave * 256) * 6144 + col;
            float a0 = 0.f, a1 = 0.f, a2 = 0.f, a3 = 0.f;
#pragma unroll 64
            for (int k = 0; k < 256; ++k) { const float wv = __builtin_nontemporal_load(wp + (size_t)k * 6144); const f32x4 s = *(const LAS f32x4*)(scl + (wave * 256 + k) * 4);
                a0 += s[0] * wv; a1 += s[1] * wv; a2 += s[2] * wv; a3 += s[3] * wv; }
            red[(wave * 4 + 0) * 64 + lane] = a0; red[(wave * 4 + 1) * 64 + lane] = a1; red[(wave * 4 + 2) * 64 + lane] = a2; red[(wave * 4 + 3) * 64 + lane] = a3;
            __syncthreads();
            if (tid < 256) { const int b = tid >> 6; float s = 0.f;
#pragma unroll
                for (int w = 0; w < 8; ++w) s += red[(w * 4 + b) * 64 + lane];
                if (lane < 48) modb[(size_t)(l * NB + b) * 6144 + col] = s + ada_b[l * 6144 + col]; }
            __syncthreads();
        }
        for (int i = bx * NTHREADS + tid; i < T * 32; i += G * NTHREADS) { const int t = i >> 5, j = i & 31;
            const float inv = 1.0f / powf(10000.0f, (float)(2 * j) * (1.0f / 64.0f)); const float ang = (float)positions[t] * inv;
            cosb[i] = cosf(ang); sinb[i] = sinf(ang); }
        for (int i = bx * NTHREADS + tid; i < DEPTH * INCP; i += G * NTHREADS) { const int l = i / INCP, c = i % INCP;
            biasb[i] = (c >= Z_CV && c < Z_CG) ? glu_b[l * 2048 + (c - Z_CV)] : 0.f; }
        {
            LAS float* scr = (LAS float*)(lds + 40960 + wave * 8448);
            constexpr int I0 = 5120, I1 = I0 + 512, I2 = I1 + 384, I3 = I2 + 128, I4 = I3 + 512, I5 = I4 + 2048;
            float va[32], vb[32]; CvtDst da, db;
#define CVT_ISSUE(IT, V, D) { const int it = (IT); \
                const int l = it / I5; int r = it % I5; \
                const float* W; int Nsrc, Ksrc, Kout, nN; bf16_t* WT; int mat; \
                if (r < I0) { mat = 0; W = w_in + (size_t)l * DM * INC; Nsrc = INC; Ksrc = DM; Kout = DM; nN = INCP / 32; WT = Win_t + (size_t)l * INCP * DM; } \
                else if (r < I1) { r -= I0; mat = 1; W = w_q_up + (size_t)l * QL * 1536; Nsrc = 1536; Ksrc = QL; Kout = KQ; nN = 64; WT = Wq_t + (size_t)l * 2048 * KQ; } \
                else if (r < I2) { r -= I1; mat = 2; W = w_kv_up + (size_t)l * KVL * 2048; Nsrc = 2048; Ksrc = KVL; Kout = KK; nN = 64; WT = Wk_t + (size_t)l * 2048 * KK; } \
                else if (r < I3) { r -= I2; mat = 3; W = w_kv_up + (size_t)l * KVL * 2048; Nsrc = 2048; Ksrc = KVL; Kout = KV; nN = 32; WT = Wv_t + (size_t)l * 1024 * KV; } \
                else if (r < I4) { r -= I3; mat = 4; W = w_pw + (size_t)l * DC * DC; Nsrc = DC; Ksrc = DC; Kout = DC; nN = 32; WT = Wpw_t + (size_t)l * DC * DC; } \
                else { r -= I4; mat = 5; W = w_out + (size_t)l * DM * DM; Nsrc = DM; Ksrc = DM; Kout = DM; nN = 64; WT = Wout_t + (size_t)l * DM * DM; } \
                const int kb = r / nN, nb = r % nN, n0 = nb * 32, k0 = kb * 64, n = n0 + (lane & 31); \
                int col = n, idk = -1; \
                if (mat == 0) col = n < INC ? n : -1; \
                else if (mat == 1) { const int hc = hmap(n & 255); col = hc >= 0 ? (n >> 8) * QKD + hc : -1; } \
                else if (mat == 2) { const int hc = hmap(n & 255); if (hc < 0) col = -1; else if (hc < 128) col = (n >> 8) * 256 + hc; else { col = -1; idk = 256 + (hc - 128); } } \
                else if (mat == 3) col = (n >> 7) * 256 + 128 + (n & 127); \
                const float* gk = (mat == 1) ? q_lat_g + l * QL : (mat == 2 || mat == 3) ? kv_lat_g + l * KVL : nullptr; \
                D.WT = WT; D.Kout = Kout; D.n0 = n0; D.k0 = k0; cvt_load(V, W, gk, Nsrc, Ksrc, col, idk, k0, lane); }
            for (int rv_ = 0; rv_ < REP_CVT; ++rv_) {
                int it0 = gw;
                if (it0 < DEPTH * I5) CVT_ISSUE(it0, va, da)
                for (; it0 < DEPTH * I5; it0 += 2 * NGW) {
                    const bool hb = it0 + NGW < DEPTH * I5, ha = it0 + 2 * NGW < DEPTH * I5;
                    if (hb) CVT_ISSUE(it0 + NGW, vb, db)
                    cvt_store(va, da.WT, da.Kout, da.n0, da.k0, scr, lane);
                    if (ha) CVT_ISSUE(it0 + 2 * NGW, va, da)
                    if (hb) cvt_store(vb, db.WT, db.Kout, db.n0, db.k0, scr, lane);
                }
            }
#undef CVT_ISSUE
        }
    }
    SEAM(0);

#pragma unroll 1
    for (int l = 0; l < DEPTH; ++l) {
        const int pb = 1 + PH_PER_LAYER * l;
        for (int rep_ = 0; rep_ < REP_A; ++rep_) if (EN_A && IN(pb)) {
            PHASE_BEGIN();
            const float* xin = (l == 0) ? INP(0) : (const float*)ap->out; const float* mod_l = (const float*)(ws + WS_MOD) + (size_t)l * NB * 6144;
            bf16_t* Hb = (bf16_t*)(ws + WS_H);
            const float* g = INP(5) + l * DM;
            for (int row0 = gw * 8; row0 < T; row0 += NGW * 8) {
                const int b = row0 / SEQ;
                f32x4 gs[8], sh[8];
#pragma unroll
                for (int j = 0; j < 8; ++j) { const int col = 4 * lane + 256 * j; const f32x4 g4 = *(const f32x4*)(g + col), s4 = *(const f32x4*)(mod_l + b * 6144 + 2048 + col);
                    gs[j] = g4 * (1.0f + s4); sh[j] = *(const f32x4*)(mod_l + b * 6144 + col); }
#pragma unroll 2
                for (int r = 0; r < 8; ++r) { const float* xr = xin + (size_t)(row0 + r) * DM + 4 * lane; f32x4 v[8]; float ss = 0.f;
#pragma unroll
                    for (int j = 0; j < 8; ++j) { v[j] = __builtin_nontemporal_load((const f32x4*)(xr + 256 * j)); ss +=     (v[j][0] * v[j][0] + v[j][1] * v[j][1]) + (v[j][2] * v[j][2] + v[j][3] * v[j][3]); }
                    const float rinv = __builtin_amdgcn_rsqf(wave_sum(ss) * (1.0f / DM) + EPS);
                    bf16_t* hr = Hb + (size_t)(row0 + r) * DM + 4 * lane;
#pragma unroll
                    for (int j = 0; j < 8; ++j) { const f32x4 o = v[j] * rinv * gs[j] + sh[j]; u32x2 w; w.x = cvt_pk_bf16(o[0], o[1]); w.y = cvt_pk_bf16(o[2], o[3]); *(u32x2*)(hr + 256 * j) = w; } }
            }
        }
        SEAM(pb);
        for (int rep_ = 0; rep_ < REP_B; ++rep_) if (EN_B && IN(pb + 1)) {
            PHASE_BEGIN();
            bf16_t* Hb = (bf16_t*)(ws + WS_H); bf16_t* Zb = (bf16_t*)(ws + WS_Z); bf16_t* Win_t = (bf16_t*)(ws + WS_WIN); float* biasb = (float*)(ws + WS_BIAS);
            pg8::Gemm g{Hb, Win_t + (size_t)l * INCP * DM, T, INCP, DM, DM, DM}; pg8::StaticOrder S; { int bxo = bx; asm volatile("" : "+s"(bxo)); S.init(T, INCP, G, bxo, WGM_B); }
            pg8::EpiZ E{Zb, INC, biasb + l * INCP, INC, (float*)(ws + WS_SSQ)};
            pg8::gemm_phase<pg8::EpiZ, pg8::StaticOrder, true, true>(lds, g, S, E);
        }
        SEAM(pb + 1);
        for (int rep_ = 0; rep_ < REP_C2; ++rep_) if (EN_C2 && IN(pb + 2)) {
            PHASE_BEGIN();
            bf16_t* Zb = (bf16_t*)(ws + WS_Z); bf16_t* U2 = (bf16_t*)(ws + WS_U2); const float* ssq = (const float*)(ws + WS_SSQ);
            const float* dw_w = INP(14); const float* dw_b = INP(15); const float* conv_ln_g = INP(16); const float* conv_ln_b = INP(17);
            bf16_t* Qb = (bf16_t*)(ws + WS_Q); bf16_t* Kb = (bf16_t*)(ws + WS_K); bf16_t* Vb = (bf16_t*)(ws + WS_V);
            bf16_t* Wq_t = (bf16_t*)(ws + WS_WQ); bf16_t* Wk_t = (bf16_t*)(ws + WS_WK); bf16_t* Wv_t = (bf16_t*)(ws + WS_WV); float* cosb = (float*)(ws + WS_COS); float* sinb = (float*)(ws + WS_SIN);
            const float* q_norm_g = INP(11); const float* k_norm_g = INP(12);
            LAS float* P = (LAS float*)(lds + EXCH_OFF);
            { pg8::Gemm g{Zb, Wq_t + (size_t)l * 2048 * KQ, T, 2048, KQ, INC, KQ}; pg8::StaticOrder S; { int bxo = bx; asm volatile("" : "+s"(bxo)); S.init(T, 2048, G, bxo, WGM_QK); }
              pg8::EpiHead E{Qb, q_norm_g + l * QKD, cosb, sinb, P, ssq, 1};
              pg8::gemm_phase<pg8::EpiHead, pg8::StaticOrder, true, true>(lds, g, S, E); }
            { pg8::Gemm g{Zb + Z_KVL, Wk_t + (size_t)l * 2048 * KK, T, 2048, KK, INC, KK};     pg8::StaticOrder S; { int bxo = bx; asm volatile("" : "+s"(bxo)); S.init(T, 2048, G, bxo, WGM_QK); }
              pg8::EpiHead E{Kb, k_norm_g + l * QKD, cosb, sinb, P, ssq, 0};
              pg8::gemm_phase<pg8::EpiHead, pg8::StaticOrder, true, true>(lds, g, S, E); }
            { pg8::Gemm g{Zb + Z_KVL, Wv_t + (size_t)l * 1024 * KV, T, 1024, KV, INC, KV}; pg8::StaticOrder S; { int bxo = bx; asm volatile("" : "+s"(bxo)); S.init(T, 1024, G, bxo, WGM_V); }
              pg8::EpiV E{Vb, ssq};
              pg8::gemm_phase<pg8::EpiV, pg8::StaticOrder, true, true>(lds, g, S, E); }
            {
                LAS bf16_t* ubuf = (LAS bf16_t*)lds;
                LAS float* red = (LAS float*)(lds + 126976);
                const int c0 = 2 * tid;
                const float* dww = dw_w + (size_t)l * CK * DC;
                const int vcu_c = (G % 8 == 0) ? (bx % 8) * (G / 8) + bx / 8 : bx, ipb_c = (T / 32 + G - 1) / G;
                for (int rc_ = 0; rc_ < REP_CONV; ++rc_) for (int item = vcu_c * ipb_c; item < T / 32 && item < (vcu_c + 1) * ipb_c; ++item) {
                    const int t0 = item * 32, s0 = t0 % SEQ;
#pragma unroll 8
                    for (int itc = 0; itc < 16; ++itc) { const int ck = tid + NTHREADS * itc; if (ck < 62 * 128) { const int si = ck >> 7, c8 = (ck & 127) * 8; u32x4 o = {0u, 0u, 0u, 0u};
                        if (s0 - 30 + si >= 0) { const bf16_t* zr = Zb + (size_t)(t0 - 30 + si) * INC; const u32x4 vv = *(const u32x4*)(zr + Z_CV + c8), gg = *(const u32x4*)(zr + Z_CGL + c8);
                            o.x = cvt_pk_bf16(bf_lo(vv.x) * fast_sigmoid(bf_lo(gg.x)), bf_hi(vv.x) * fast_sigmoid(bf_hi(gg.x))); o.y = cvt_pk_bf16(bf_lo(vv.y) * fast_sigmoid(bf_lo(gg.y)), bf_hi(vv.y) * fast_sigmoid(bf_hi(gg.y)));
                            o.z = cvt_pk_bf16(bf_lo(vv.z) * fast_sigmoid(bf_lo(gg.z)), bf_hi(vv.z) * fast_sigmoid(bf_hi(gg.z))); o.w = cvt_pk_bf16(bf_lo(vv.w) * fast_sigmoid(bf_lo(gg.w)), bf_hi(vv.w) * fast_sigmoid(bf_hi(gg.w))); }
                        *(LAS u32x4*)(ubuf + si * DC + c8) = o; } }
                    __syncthreads();
                    f32x2 wv[CK];
#pragma unroll
                    for (int j = 0; j < CK; ++j) wv[j] = *(const f32x2*)(dww + j * DC + c0);
                    f32x2 av[32];
                    { const f32x2 bb = *(const f32x2*)(dw_b + l * DC + c0);
#pragma unroll
                      for (int tt = 0; tt < 32; ++tt) av[tt] = bb; }
#define CS(SI) { const unsigned uu = *(const LAS unsigned*)(ubuf + (SI) * DC + c0); conv_step<SI>(av, wv, (f32x2){bf_lo(uu), bf_hi(uu)}); }
                    CS(0) CS(1) CS(2) CS(3) CS(4) CS(5) CS(6) CS(7) CS(8) CS(9) CS(10) CS(11) CS(12) CS(13) CS(14) CS(15) CS(16) CS(17) CS(18) CS(19) CS(20) CS(21) CS(22) CS(23) CS(24) CS(25) CS(26) CS(27) CS(28) CS(29) CS(30) CS(31) CS(32) CS(33) CS(34) CS(35) CS(36) CS(37) CS(38) CS(39) CS(40) CS(41) CS(42) CS(43) CS(44) CS(45) CS(46) CS(47) CS(48) CS(49) CS(50) CS(51) CS(52) CS(53) CS(54) CS(55) CS(56) CS(57) CS(58) CS(59) CS(60) CS(61)
#undef CS
                    float v[64];
#pragma unroll
                    for (int tt = 0; tt < 32; ++tt) { v[tt] = av[tt][0] + av[tt][1]; v[32 + tt] = av[tt][0] * av[tt][0] + av[tt][1] * av[tt][1]; }
                    { const bool up = (lane & 32) != 0;
#pragma unroll
                      for (int i = 0; i < 32; ++i) { const float send = up ? v[i] : v[i + 32]; const float keep = up ? v[i + 32] : v[i]; v[i] = keep + xswap32(send, up); } }
#define TRED(STEP) { const bool up = (lane & STEP) != 0; _Pragma("unroll") for (int i = 0; i < STEP; ++i) { const float send = up ? v[i] : v[i + STEP]; const float keep = up ? v[i + STEP] : v[i]; v[i] = keep + xshfl<STEP>(send); } }
                    TRED(16) TRED(8) TRED(4) TRED(2) TRED(1)
#undef TRED
                    red[wave * 64 + lane] = v[0];
                    __syncthreads();
                    float tot = 0.f;
#pragma unroll
                    for (int w = 0; w < 8; ++w) tot += red[w * 64 + lane];
                    const float other = xswap32(tot, lane >= 32);
                    const float s1 = lane < 32 ? tot : other, s2 = lane < 32 ? other : tot;
                    const float mean = s1 * (1.0f / DC), var = s2 * (1.0f / DC) - mean * mean, rstd = __builtin_amdgcn_rsqf(var + EPS);
                    const f32x2 lg = *(const f32x2*)(conv_ln_g + l * DC + c0), lb = *(const f32x2*)(conv_ln_b + l * DC + c0);
#pragma unroll
                    for (int tt = 0; tt < 32; ++tt) { const float m = __int_as_float(__builtin_amdgcn_readlane(__float_as_int(mean), tt)), rs = __int_as_float(__builtin_amdgcn_readlane(__float_as_int(rstd), tt));
                        const float o0 = (av[tt][0] - m) * rs * lg[0] + lb[0], o1 = (av[tt][1] - m) * rs * lg[1] + lb[1];
                        *(unsigned*)(U2 + (size_t)(t0 + tt) * DC + c0) = cvt_pk_bf16(fast_silu(o0), fast_silu(o1)); }
                    __syncthreads();
                }
            }
        }
        SEAM(pb + 2);
        if (EN_D && IN(pb + 3)) {
            PHASE_BEGIN();
            bf16_t* Hb = (bf16_t*)(ws + WS_H); bf16_t* Zb = (bf16_t*)(ws + WS_Z); bf16_t* Qb = (bf16_t*)(ws + WS_Q); bf16_t* Kb = (bf16_t*)(ws + WS_K); bf16_t* Vb = (bf16_t*)(ws + WS_V);
            bf16_t* U2 = (bf16_t*)(ws + WS_U2); bf16_t* Wpw_t = (bf16_t*)(ws + WS_WPW); const float* b_pw = INP(19);
            const int vcu = (G % 8 == 0) ? (bx % 8) * (G / 8) + bx / 8 : bx;
            for (int rep_ = 0; rep_ < REP_ATT; ++rep_) for (int it = vcu; it < NB * NH * 8; it += G) {
                const int bh = it >> 3, xq = it & 7, b = bh / NH, h = bh % NH;
                const bf16_t* Qh = Qb + (size_t)bh * SEQ * QKD; const bf16_t* Kh = Kb + (size_t)bh * SEQ * QKD; const bf16_t* Vh = Vb + (size_t)bh * SEQ * VD;
                bf16_t* mixp = Hb + (size_t)b * SEQ * DM + h * VD; const bf16_t* zg = Zb + (size_t)b * SEQ * INC + Z_MG + h * VD;
#pragma unroll 1
                for (int pass = 0; pass < 2 * EN_ATT; ++pass) att::attn_block(Qh, Kh, Vh, pass ? xq : 15 - xq, mixp, zg, (LAS char*)lds);
            }
            for (int rep_ = 0; rep_ < REP_PW; ++rep_) if (EN_PW) { pg8::Gemm g{U2, Wpw_t + (size_t)l * DC * DC, T, DC, DC, DC, DC}; pg8::StaticOrder S; { int bxo = bx; asm volatile("" : "+s"(bxo)); S.init(T, DC, G, bxo, WGM_PW); }
              pg8::EpiPw E{Hb, Zb, b_pw + l * DC};
              pg8::gemm_phase<pg8::EpiPw, pg8::StaticOrder, true, true>(lds, g, S, E); }
        }
        SEAM(pb + 3);
        for (int rep_ = 0; rep_ < (l == 0 ? REP_E0 : 1); ++rep_) if (EN_E && IN(pb + 4)) {
            PHASE_BEGIN();
            bf16_t* Hb = (bf16_t*)(ws + WS_H); bf16_t* Wout_t = (bf16_t*)(ws + WS_WOUT);
            const float* xin = (l == 0) ? INP(0) : (const float*)ap->out; const float* mod_l = (const float*)(ws + WS_MOD) + (size_t)l * NB * 6144;
            pg8::Gemm g{Hb, Wout_t + (size_t)l * DM * DM, T, DM, DM, DM, DM}; pg8::StaticOrder S; { int bxo = bx; asm volatile("" : "+s"(bxo)); S.init(T, DM, G, bxo, WGM_E); }
            pg8::EpiOut E{xin, ap->out, mod_l + 4096};
            pg8::gemm_phase<pg8::EpiOut, pg8::StaticOrder, true, true>(lds, g, S, E);
        }
        SEAM(pb + 4);
    }
#undef IN
#undef SEAM
}

extern "C" void kernel_launch(void* const* d_in, const int* in_sizes, int n_in, void* d_out, int out_size, void* d_ws, size_t ws_size, hipStream_t stream) {
    static int grid = 0;
    if (grid == 0) {
        if (n_in != 21 || in_sizes[0] != T * DM || out_size != T * DM || ws_size < WS_END) { fprintf(stderr, "kernel_launch: unexpected shapes (n_in %d, in0 %d, out %d, ws %zu)\n", n_in, n_in > 0 ? in_sizes[0] : -1, out_size, ws_size); grid = -1; return; }
        int dev = 0, cus = 0, per_cu = 0;
        (void)hipGetDevice(&dev); (void)hipDeviceGetAttribute(&cus, hipDeviceAttributeMultiprocessorCount, dev);
        if (hipFuncSetAttribute((const void*)mk_fwd, hipFuncAttributeMaxDynamicSharedMemorySize, LDS_BYTES) != hipSuccess) { fprintf(stderr, "kernel_launch: hipFuncSetAttribute failed\n"); grid = -1; return; }
        if (hipOccupancyMaxActiveBlocksPerMultiprocessor(&per_cu, (const void*)mk_fwd, NTHREADS, LDS_BYTES) != hipSuccess || per_cu < 1) { fprintf(stderr, "kernel_launch: occupancy query says %d blocks per CU\n", per_cu); per_cu = 1; }
        (void)hipGetLastError();
        grid = cus * 1;
        fprintf(stderr, "kernel_launch: %d CUs, occupancy %d, grid %d\n", cus, per_cu, grid);
    }
    if (grid < 0) return;
    Args a{};
    for (int i = 0; i < 21; ++i) a.in[i] = (const float*)d_in[i];
    a.out = (float*)d_out; a.ws = (unsigned char*)d_ws;
#if MK_ONE_LAUNCH
    (void)hipMemsetAsync(d_ws, 0, 16384, stream);
    a.ph_lo = 0; a.ph_hi = N_PHASES;
    void* args[] = {&a};
    hipError_t e = hipLaunchCooperativeKernel((const void*)mk_fwd, dim3(grid), dim3(NTHREADS), args, LDS_BYTES, stream);
    if (e != hipSuccess) fprintf(stderr, "kernel_launch: cooperative launch failed: %s (grid %d)\n", hipGetErrorString(e), grid);
#else
    for (int p = 0; p < N_PHASES; ++p) { a.ph_lo = p; a.ph_hi = p + 1; hipLaunchKernelGGL(mk_fwd, dim3(grid), dim3(NTHREADS), LDS_BYTES, stream, a); }
#endif
}
```
